# Optimizing an MI355X kernel written in HIP

```python
import math
import jax, jax.numpy as jnp
from jax import lax
import numpy as np

D_MODEL = 2048
BATCH = 4
SEQ = 8192
DEPTH = 2

HEAD_DIM = 64
HEADS_PER_MIXER = 8
N_MIXERS = 4
MIX_WIDTH = N_MIXERS * HEADS_PER_MIXER * HEAD_DIM
D_FF = 4 * D_MODEL
QBLK = 128
EPS = 1e-6
NEG = -1e30
BIG = 1e30

N_BUCKETS = 32
MAX_EXACT = 16
MAX_DISTANCE = 4096
N_BIAS_HEADS = 3 * HEADS_PER_MIXER

NSA_KV_GROUPS = 2
NSA_Q_PER_GROUP = HEADS_PER_MIXER // NSA_KV_GROUPS
NSA_KV_WIDTH = NSA_KV_GROUPS * HEAD_DIM
NSA_CMP_LEN = 32
NSA_CMP_STRIDE = 16
NSA_CMP_HIDDEN = 256
NSA_SEL_LEN = 64
NSA_TOP_N = 16
NSA_WINDOW = 512

MOBA_BLOCK = 256
MOBA_TOPK = 3

LONGNET_PATTERNS = ((128, 1), (512, 4), (2048, 16))

GW = HEADS_PER_MIXER * HEAD_DIM
PROJ_SIZES = (
    GW, NSA_KV_WIDTH, NSA_KV_WIDTH, NSA_KV_WIDTH, NSA_KV_WIDTH, NSA_KV_WIDTH, NSA_KV_WIDTH, 3 * HEADS_PER_MIXER,
    GW, GW, GW,
    GW, GW, GW, HEADS_PER_MIXER,
    GW, GW, GW,
)
PROJ_WIDTH = 5920

kernel_name = "hybrid_nsa_moba_fox_longnet_block"


def rmsnorm(x, g):
    xf = x.astype(jnp.float32)
    y = xf * lax.rsqrt(jnp.mean(xf * xf, axis=-1, keepdims=True) + EPS)
    return (y * g.astype(jnp.float32)).astype(x.dtype)


def t5_bucket(dist):
    dist = jnp.maximum(dist, 0)
    rel = jnp.log(jnp.maximum(dist, 1).astype(jnp.float32) / MAX_EXACT) / math.log(MAX_DISTANCE / MAX_EXACT)
    large = jnp.minimum(MAX_EXACT + (rel * (N_BUCKETS - MAX_EXACT)).astype(jnp.int32), N_BUCKETS - 1)
    return jnp.where(dist < MAX_EXACT, dist, large)


def masked_softmax(s, mask):
    s = jnp.where(mask, s, NEG)
    p = jax.nn.softmax(s, axis=-1)
    return jnp.where(mask, p, 0.0)


def merge_blocks(o):
    o = jnp.moveaxis(o, 0, -3)
    return o.reshape(o.shape[:-3] + (o.shape[-3] * o.shape[-2], o.shape[-1]))


def banded_attention(q, k, v, max_dist, dist_step, bias_tab):
    B, G, R, L, hd = q.shape
    nb = -(-L // QBLK)
    Lp = nb * QBLK
    nw = -(-max_dist // QBLK)
    q = jnp.pad(q, ((0, 0), (0, 0), (0, 0), (0, Lp - L), (0, 0)))
    kv_pad = ((0, 0), (0, 0), (nw * QBLK, Lp - L), (0, 0))
    kb = jnp.pad(k, kv_pad).reshape(B, G, nb + nw, QBLK, hd)
    vb = jnp.pad(v, kv_pad).reshape(B, G, nb + nw, QBLK, hd)
    blk_idx = jnp.arange(nb)[:, None] + jnp.arange(nw + 1)[None, :]
    kw = kb[:, :, blk_idx].reshape(B, G, nb, (nw + 1) * QBLK, hd)
    vw = vb[:, :, blk_idx].reshape(B, G, nb, (nw + 1) * QBLK, hd)
    qb = q.reshape(B, G, R, nb, QBLK, hd)
    s = jnp.einsum('bgrnqd,bgnkd->bgrnqk', qb, kw).astype(jnp.float32) * (hd ** -0.5)
    qpos = jnp.arange(Lp).reshape(nb, QBLK)
    kpos = (blk_idx[:, :, None] * QBLK + jnp.arange(QBLK)).reshape(nb, -1) - nw * QBLK
    dist = qpos[:, :, None] - kpos[:, None, :]
    mask = (dist >= 0) & (dist <= max_dist) & (kpos[:, None, :] >= 0)
    bias = jnp.moveaxis(bias_tab[t5_bucket(dist * dist_step)], -1, 0).reshape(G, R, nb, QBLK, -1)
    s = jnp.where(mask, s + bias, NEG)
    lse = jax.nn.logsumexp(s, axis=-1)
    p = jnp.exp(s - lse[..., None])
    o = jnp.einsum('bgrnqk,bgnkd->bgrnqd', p.astype(v.dtype), vw)
    o = o.reshape(B, G, R, Lp, hd)[:, :, :, :L]
    lse = lse.reshape(B, G, R, Lp)[..., :L]
    return o, lse


def nsa_compress(kx, pe, w1, w2):
    B, G, T, hd = kx.shape
    nc = (T - NSA_CMP_LEN) // NSA_CMP_STRIDE + 1
    idx = jnp.arange(nc)[:, None] * NSA_CMP_STRIDE + jnp.arange(NSA_CMP_LEN)[None, :]
    blk = kx[:, :, idx] + pe
    hmid = jax.nn.gelu(blk.reshape(B, G, nc, NSA_CMP_LEN * hd) @ w1)
    return hmid @ w2


def nsa_attention(q, k_cmp, v_cmp, k_slc, v_slc, k_win, v_win, gate_logits,
                  cmp_pe, phik_w1, phik_w2, phiv_w1, phiv_w2, bias_tab):
    B, G, R, T, hd = q.shape
    scale = hd ** -0.5
    kc = nsa_compress(k_cmp, cmp_pe, phik_w1, phik_w2)
    vc = nsa_compress(v_cmp, cmp_pe, phiv_w1, phiv_w2)
    nc = kc.shape[2]
    ns = T // NSA_SEL_LEN
    n_sel = min(NSA_TOP_N, ns)
    c_end = jnp.arange(nc) * NSA_CMP_STRIDE + NSA_CMP_LEN - 1
    s_start = jnp.arange(ns) * NSA_SEL_LEN
    overlap = ((c_end[:, None] - NSA_CMP_LEN + 1 < s_start[None, :] + NSA_SEL_LEN)
               & (c_end[:, None] >= s_start[None, :])).astype(jnp.float32)
    kbl = k_slc.reshape(B, G, ns, NSA_SEL_LEN, hd)
    vbl = v_slc.reshape(B, G, ns, NSA_SEL_LEN, hd)
    tab_gr = bias_tab.T.reshape(G, R, N_BUCKETS)
    b_i = jnp.arange(B)[:, None, None, None]
    g_i = jnp.arange(G)[None, :, None, None]
    g6 = jnp.arange(G)[None, :, None, None, None, None]
    r6 = jnp.arange(R)[None, None, :, None, None, None]
    blk_id = jnp.arange(ns)

    def block(i):
        t = i * QBLK + jnp.arange(QBLK)
        qb = lax.dynamic_slice_in_dim(q, i * QBLK, QBLK, axis=3)
        sc = jnp.einsum('bgrqd,bgcd->bgrqc', qb, kc).astype(jnp.float32) * scale
        dc = t[:, None] - c_end[None, :]
        sc = sc + jnp.moveaxis(bias_tab[t5_bucket(dc)], -1, 0).reshape(G, R, QBLK, nc)
        pc = masked_softmax(sc, dc >= 0)
        o_c = jnp.einsum('bgrqc,bgcd->bgrqd', pc.astype(vc.dtype), vc)
        imp = jnp.einsum('bgrqc,cn->bgqn', pc, overlap)
        cur = t // NSA_SEL_LEN
        forced = (blk_id[None, :] == 0) | (blk_id[None, :] == cur[:, None]) | (blk_id[None, :] == cur[:, None] - 1)
        valid = s_start[None, :] <= t[:, None]
        imp = jnp.where(forced, BIG, jnp.where(valid, imp, NEG))
        _, sel = lax.top_k(imp, n_sel)
        ks = kbl[b_i, g_i, sel]
        vs = vbl[b_i, g_i, sel]
        ss = jnp.einsum('bgrqd,bgqnkd->bgrqnk', qb, ks).astype(jnp.float32) * scale
        spos = sel[..., None] * NSA_SEL_LEN + jnp.arange(NSA_SEL_LEN)
        ds = t[None, None, :, None, None] - spos
        ss = ss + tab_gr[g6, r6, t5_bucket(ds)[:, :, None]]
        ss = ss.reshape(B, G, R, QBLK, n_sel * NSA_SEL_LEN)
        ps = masked_softmax(ss, (ds >= 0).reshape(B, G, 1, QBLK, n_sel * NSA_SEL_LEN))
        o_s = jnp.einsum('bgrqk,bgqkd->bgrqd', ps.astype(vs.dtype),
                         vs.reshape(B, G, QBLK, n_sel * NSA_SEL_LEN, hd))
        return o_c, o_s

    o_c, o_s = lax.map(block, jnp.arange(T // QBLK))
    o_c = merge_blocks(o_c)
    o_s = merge_blocks(o_s)
    o_w, _ = banded_attention(q, k_win, v_win, NSA_WINDOW - 1, 1, bias_tab)
    gates = jax.nn.sigmoid(gate_logits.astype(jnp.float32)).reshape(B, T, 3, G, R).transpose(2, 0, 3, 4, 1)[..., None]
    o = gates[0] * o_c + gates[1] * o_s + gates[2] * o_w
    return o.reshape(B, G * R, T, hd)


def moba_attention(q, k, v, bias_tab):
    B, H, T, hd = q.shape
    scale = hd ** -0.5
    nkb = -(-T // MOBA_BLOCK)
    pad = ((0, 0), (0, 0), (0, nkb * MOBA_BLOCK - T), (0, 0))
    kb = jnp.pad(k, pad).reshape(B, H, nkb, MOBA_BLOCK, hd)
    vb = jnp.pad(v, pad).reshape(B, H, nkb, MOBA_BLOCK, hd)
    kmean = jnp.mean(kb.astype(jnp.float32), axis=3).astype(k.dtype)
    n_top = min(MOBA_TOPK, nkb)
    tab_t = bias_tab.T
    b_i = jnp.arange(B)[:, None, None, None]
    h_i = jnp.arange(H)[None, :, None, None]
    h5 = jnp.arange(H)[None, :, None, None, None]

    def block(i):
        t = i * QBLK + jnp.arange(QBLK)
        cur = (i * QBLK) // MOBA_BLOCK
        qb = lax.dynamic_slice_in_dim(q, i * QBLK, QBLK, axis=2)
        gate = jnp.einsum('bhqd,bhnd->bhqn', qb, kmean).astype(jnp.float32)
        gate = jnp.where(jnp.arange(nkb) < cur, gate, NEG)
        _, sel = lax.top_k(gate, n_top)
        ks = kb[b_i, h_i, sel]
        vs = vb[b_i, h_i, sel]
        s_sel = jnp.einsum('bhqd,bhqnkd->bhqnk', qb, ks).astype(jnp.float32) * scale
        pos_sel = sel[..., None] * MOBA_BLOCK + jnp.arange(MOBA_BLOCK)
        s_sel = s_sel + tab_t[h5, t5_bucket(t[None, None, :, None, None] - pos_sel)]
        mask_sel = jnp.broadcast_to((sel < cur)[..., None], pos_sel.shape)
        k_own = lax.dynamic_index_in_dim(kb, cur, axis=2, keepdims=False)
        v_own = lax.dynamic_index_in_dim(vb, cur, axis=2, keepdims=False)
        d_own = t[:, None] - (cur * MOBA_BLOCK + jnp.arange(MOBA_BLOCK))[None, :]
        s_own = jnp.einsum('bhqd,bhkd->bhqk', qb, k_own).astype(jnp.float32) * scale + tab_t[:, t5_bucket(d_own)]
        n_sel_keys = n_top * MOBA_BLOCK
        s = jnp.concatenate([s_sel.reshape(B, H, QBLK, n_sel_keys), s_own], axis=-1)
        mask = jnp.concatenate([mask_sel.reshape(B, H, QBLK, n_sel_keys),
                                jnp.broadcast_to(d_own >= 0, (B, H, QBLK, MOBA_BLOCK))], axis=-1)
        p = masked_softmax(s, mask).astype(v.dtype)
        return (jnp.einsum('bhqk,bhqkd->bhqd', p[..., :n_sel_keys], vs.reshape(B, H, QBLK, n_sel_keys, hd))
                + jnp.einsum('bhqk,bhkd->bhqd', p[..., n_sel_keys:], v_own))

    return merge_blocks(lax.map(block, jnp.arange(T // QBLK)))


def fox_attention(q, k, v, log_f):
    B, H, T, hd = q.shape
    scale = hd ** -0.5
    c = jnp.cumsum(log_f, axis=-1)
    kpos = jnp.arange(T)

    def block(i):
        t = i * QBLK + jnp.arange(QBLK)
        qb = lax.dynamic_slice_in_dim(q, i * QBLK, QBLK, axis=2)
        cq = lax.dynamic_slice_in_dim(c, i * QBLK, QBLK, axis=2)
        s = jnp.einsum('bhqd,bhkd->bhqk', qb, k).astype(jnp.float32) * scale + (cq[..., None] - c[:, :, None, :])
        p = masked_softmax(s, kpos[None, :] <= t[:, None])
        return jnp.einsum('bhqk,bhkd->bhqd', p.astype(v.dtype), v)

    return merge_blocks(lax.map(block, jnp.arange(T // QBLK)))


def dilated_attention(q, k, v, bias_tab):
    B, H, T, hd = q.shape
    outs, lses = [], []
    for window, dil in LONGNET_PATTERNS:
        L = T // dil

        def fold(z):
            return z.reshape(B, H, L, dil, hd).transpose(0, 3, 1, 2, 4).reshape(B * dil, H, L, hd)

        o, lse = banded_attention(fold(q)[:, :, None], fold(k), fold(v), window // dil, dil, bias_tab)
        outs.append(o[:, :, 0].reshape(B, dil, H, L, hd).transpose(0, 2, 3, 1, 4).reshape(B, H, T, hd))
        lses.append(lse[:, :, 0].reshape(B, dil, H, L).transpose(0, 2, 3, 1).reshape(B, H, T))
    w = jax.nn.softmax(jnp.stack(lses, axis=0), axis=0)
    out = w[0][..., None] * outs[0] + w[1][..., None] * outs[1] + w[2][..., None] * outs[2]
    return out.astype(q.dtype)


def hybrid_mixer(h, w_in, w_out, cmp_pe, phik_w1, phik_w2, phiv_w1, phiv_w2, fox_bias, rel_bias):
    B, T, _ = h.shape
    proj = h @ w_in
    splits = [int(s) for s in np.cumsum(PROJ_SIZES)[:-1]]
    (qa, kca, vca, ksa, vsa, kwa, vwa, ga,
     qb, kb, vb,
     qc, kc, vc, fc,
     qd, kd, vd) = jnp.split(proj, splits, axis=-1)

    def heads(z):
        n = z.shape[-1] // HEAD_DIM
        return z.reshape(B, T, n, HEAD_DIM).transpose(0, 2, 1, 3)

    hm = HEADS_PER_MIXER
    qa_g = heads(qa).reshape(B, NSA_KV_GROUPS, NSA_Q_PER_GROUP, T, HEAD_DIM)
    o_a = nsa_attention(qa_g, heads(kca), heads(vca), heads(ksa), heads(vsa), heads(kwa), heads(vwa), ga,
                        cmp_pe, phik_w1, phik_w2, phiv_w1, phiv_w2, rel_bias[:, 0:hm])
    o_b = moba_attention(heads(qb), heads(kb), heads(vb), rel_bias[:, hm:2 * hm])
    log_f = jax.nn.log_sigmoid((fc + fox_bias).astype(jnp.float32)).transpose(0, 2, 1)
    o_c = fox_attention(heads(qc), heads(kc), heads(vc), log_f)
    o_d = dilated_attention(heads(qd), heads(kd), heads(vd), rel_bias[:, 2 * hm:3 * hm])
    o = jnp.concatenate([o_a.astype(h.dtype), o_b.astype(h.dtype), o_c.astype(h.dtype), o_d.astype(h.dtype)], axis=1)
    o = o.transpose(0, 2, 1, 3).reshape(B, T, MIX_WIDTH)
    return o @ w_out


def setup_inputs(seed: int = 0) -> dict:
    key = jax.random.key(seed)
    ks = jax.random.split(key, 17)

    def nrm(k, shape, fan):
        return jax.random.normal(k, shape, jnp.float32) * fan ** -0.5

    def gain(k):
        return 1.0 + 0.05 * jax.random.normal(k, (DEPTH, D_MODEL), jnp.float32)

    cmp_in = NSA_CMP_LEN * HEAD_DIM
    return {
        "x": jax.random.normal(ks[0], (BATCH, SEQ, D_MODEL), jnp.float32),
        "w_in": nrm(ks[1], (DEPTH, D_MODEL, PROJ_WIDTH), D_MODEL),
        "w_out": nrm(ks[2], (DEPTH, MIX_WIDTH, D_MODEL), MIX_WIDTH),
        "g_mix_pre": gain(ks[3]),
        "g_mix_post": gain(ks[4]),
        "g_mlp_pre": gain(ks[5]),
        "g_mlp_post": gain(ks[6]),
        "w_up": nrm(ks[7], (DEPTH, D_MODEL, D_FF), D_MODEL),
        "w_down": nrm(ks[8], (DEPTH, D_FF, D_MODEL), D_FF),
        "cmp_pe": 0.1 * jax.random.normal(ks[9], (DEPTH, NSA_CMP_LEN, HEAD_DIM), jnp.float32),
        "phik_w1": nrm(ks[10], (DEPTH, cmp_in, NSA_CMP_HIDDEN), cmp_in),
        "phik_w2": nrm(ks[11], (DEPTH, NSA_CMP_HIDDEN, HEAD_DIM), NSA_CMP_HIDDEN),
        "phiv_w1": nrm(ks[12], (DEPTH, cmp_in, NSA_CMP_HIDDEN), cmp_in),
        "phiv_w2": nrm(ks[13], (DEPTH, NSA_CMP_HIDDEN, HEAD_DIM), NSA_CMP_HIDDEN),
        "fox_bias": 4.0 + 0.5 * jax.random.normal(ks[14], (DEPTH, HEADS_PER_MIXER), jnp.float32),
        "rel_bias": 0.5 * jax.random.normal(ks[15], (N_BUCKETS, N_BIAS_HEADS), jnp.float32),
    }


def reference(x, w_in, w_out, g_mix_pre, g_mix_post, g_mlp_pre, g_mlp_post, w_up, w_down,
              cmp_pe, phik_w1, phik_w2, phiv_w1, phiv_w2, fox_bias, rel_bias):
    for l in range(DEPTH):
        h = rmsnorm(x, g_mix_pre[l])
        mix = hybrid_mixer(h, w_in[l], w_out[l], cmp_pe[l], phik_w1[l], phik_w2[l],
                           phiv_w1[l], phiv_w2[l], fox_bias[l], rel_bias)
        x = x + rmsnorm(mix, g_mix_post[l])
        h2 = rmsnorm(x, g_mlp_pre[l])
        y = jnp.square(jax.nn.relu(h2 @ w_up[l])) @ w_down[l]
        x = x + rmsnorm(y, g_mlp_post[l])
    return x
```

```cpp
#include <hip/hip_runtime.h>
#include <cstdio>
#include <cstdint>
#include <type_traits>
#define FUSED_ATT 1
#define N_LAUNCH_PER_PHASE 0
#ifndef REP_MOBA
#define REP_MOBA 1
#endif
#ifndef REP_FOX
#define REP_FOX 1
#endif
#ifndef REP_NSA
#define REP_NSA 1
#endif
#ifndef REP_D
#define REP_D 1
#endif
#ifndef ATT_REP
#define ATT_REP 1
#endif
#ifndef FOX_NB
#define FOX_NB 2
#endif
#ifndef GEMM_REP
#define GEMM_REP 1
#endif
#ifndef PRE_REP
#define PRE_REP 1
#endif
#ifndef P0_REP
#define P0_REP 1
#endif
namespace pg8 {
#define PG8_LAS __attribute__((address_space(3)))
typedef unsigned short bf16_t;
typedef short bf16x8 __attribute__((ext_vector_type(8)));
typedef float f32x4 __attribute__((ext_vector_type(4)));
typedef unsigned u32x4 __attribute__((ext_vector_type(4)));
constexpr int BM = 256, BK = 64, HALF = 128, HTB = HALF * BK * 2  , STAGE_BYTES = 8 * HTB, NXCD = 8, WGM = 8;

__host__ __device__ __forceinline__ int lds_byte(int r, int c) { const int st = (r >> 4) * 2 + (c >> 5), rr = r & 15, cc = c & 31, ob = rr * 64 + cc * 2; return st * 1024 + (ob ^ (((ob >> 9) & 1) << 5)); }
__host__ __device__ __forceinline__ void stage_rc(int b, int& R, int& C) { const int st = b / 1024, sb = b % 1024, swz = sb ^ (((sb >> 9) & 1) << 5); R = (st >> 1) * 16 + swz / 64; C = (st & 1) * 32 + (swz % 64) / 2; }
__host__ __device__ __forceinline__ int perm32(int rho) { const int n = rho >> 4, i = rho & 15; return 8 * (i >> 2) + 4 * n + (i & 3); }

struct Unit { int pm, pn; };
struct Gemm { const bf16_t* A; const bf16_t* Bt; int M, N, K; };

struct StaticOrder {
    int nM, nN, nwg, G, c;
    __host__ __device__ void init(int M, int N, int G_, int c_) { nM = M / BM; nN = N / BM; nwg = nM * nN; G = G_; c = c_; }
    __host__ __device__ bool next(int i, Unit& u) const {
        const long L = (long)i * G + c; if (L >= nwg) return false;
        int wgid = (int)L; { const int q = nwg / NXCD, r = nwg % NXCD, xcd = wgid % NXCD, off = wgid / NXCD; wgid = (xcd < r ? xcd * (q + 1) : r * (q + 1) + (xcd - r) * q) + off; }
        const int nig = WGM * nN, gid = wgid / nig, fm = gid * WGM, gsz = (nM - fm) < WGM ? (nM - fm) : WGM;
        u.pm = fm + ((wgid % nig) % gsz); u.pn = (wgid % nig) / gsz; return true;
    }
    __device__ __forceinline__ void a_ready(const Unit&) const {}
    __device__ __forceinline__ void done(const Unit&) const {}
};

typedef __bf16 bf16x2_cv __attribute__((ext_vector_type(2)));
typedef float f32x2_cv __attribute__((ext_vector_type(2)));
__device__ __forceinline__ unsigned cvt_pk_bf16(float lo, float hi) { const f32x2_cv v = {lo, hi}; return __builtin_bit_cast(unsigned, __builtin_convertvector(v, bf16x2_cv)); }
typedef float f32x2 __attribute__((ext_vector_type(2)));
__device__ __forceinline__ float rstd_of_sum(unsigned long long s) { return 1.f / sqrtf((float)s * (1.f / 16777216.f) * (1.f / 2048.f) + 1e-6f); }
template <int ACT, int SCL = 0, bool SQ = false> struct EpiBf16 {
    static constexpr bool PERM = true, AFTER_DRAIN = false;
    bf16_t* O; int ldc; const void* rsv;
    __device__ __forceinline__ void operator()(const f32x4 (&acc)[2][2][4][2], const Unit& u, int wr, int wc, int fr, int fq) const {
        const int row0 = u.pm * BM + wr * 64 + fr; const int col0 = u.pn * BM + wc * 32 + 8 * fq;
        const float* rs = (const float*)rsv; const unsigned long long* sq = (const unsigned long long*)rsv;
        f32x4 cs[2][2];
        if (SCL == 2) {
#pragma unroll
            for (int bj = 0; bj < 2; ++bj) {
                if (SQ) {
#pragma unroll
                    for (int e = 0; e < 4; ++e) { cs[bj][0][e] = rstd_of_sum(sq[col0 + bj * HALF + e]); cs[bj][1][e] = rstd_of_sum(sq[col0 + bj * HALF + 4 + e]); } }
                else { cs[bj][0] = *(const f32x4*)(rs + col0 + bj * HALF); cs[bj][1] = *(const f32x4*)(rs + col0 + bj * HALF + 4); } } }
#pragma unroll
        for (int ai = 0; ai < 2; ++ai)
#pragma unroll
            for (int m = 0; m < 4; ++m) { bf16_t* rowp = O + (size_t)(row0 + ai * HALF + m * 16) * ldc + col0;
                const float rsc = SCL == 1 ? (SQ ? rstd_of_sum(sq[row0 + ai * HALF + m * 16]) : rs[row0 + ai * HALF + m * 16]) : 1.f;
#pragma unroll
                for (int bj = 0; bj < 2; ++bj) { f32x4 v0 = acc[ai][bj][m][0], v1 = acc[ai][bj][m][1];
                    if (SCL == 1) { v0 = v0 * rsc; v1 = v1 * rsc; }
                    if (SCL == 2) { v0 = v0 * cs[bj][0]; v1 = v1 * cs[bj][1]; }
                    if (ACT == 2) {
#pragma unroll
                        for (int e = 0; e < 4; ++e) { float a = v0[e] > 0.f ? v0[e] : 0.f; v0[e] = a * a; float b = v1[e] > 0.f ? v1[e] : 0.f; v1[e] = b * b; }
                    }
                    u32x4 w; w.x = cvt_pk_bf16(v0[0], v0[1]); w.y = cvt_pk_bf16(v0[2], v0[3]); w.z = cvt_pk_bf16(v1[0], v1[1]); w.w = cvt_pk_bf16(v1[2], v1[3]);
                    if (ACT == 2) __builtin_nontemporal_store(w, (u32x4*)(rowp + bj * HALF)); else *(u32x4*)(rowp + bj * HALF) = w; } }
    }
};

struct PanelOrder {
    int c;
    __host__ __device__ void init(int c_) { c = c_; }
    __host__ __device__ bool next(int i, Unit& u) const { if (i >= 4) return false; const int x = c & 7, j = c >> 3; u.pm = (i * 4 + (j >> 3)) * 8 + x; u.pn = j & 7; return true; }
    __device__ __forceinline__ void a_ready(const Unit&) const {}
    __device__ __forceinline__ void done(const Unit&) const {}
};
template <bool FINAL> struct EpiNormRes {
    static constexpr bool PERM = true, AFTER_DRAIN = false;
    static constexpr int ND = 2048; static constexpr float FXS = 16777216.f, EPSN = 1e-6f;
    bf16_t* X; const float* gpost; unsigned long long* SA; unsigned long long* SB; unsigned* cnt; float* fout;
    static __device__ __forceinline__ void spin64(unsigned* p) { unsigned sp = 0; while (__hip_atomic_load(p, __ATOMIC_RELAXED, __HIP_MEMORY_SCOPE_AGENT) < 64u) { __builtin_amdgcn_s_sleep(1); if (++sp > (1u << 22)) break; } }
    __device__ __forceinline__ void operator()(const f32x4 (&acc)[2][2][4][2], const Unit& u, int wr, int wc, int fr, int fq) const {
        const int row0 = u.pm * BM + wr * 64 + fr; const int col0 = u.pn * BM + wc * 32 + 8 * fq;
#pragma unroll
        for (int ai = 0; ai < 2; ++ai)
#pragma unroll
            for (int m = 0; m < 4; ++m) { float t = 0.f;
#pragma unroll
                for (int bj = 0; bj < 2; ++bj)
#pragma unroll
                    for (int n = 0; n < 2; ++n) { const f32x4 v = acc[ai][bj][m][n]; t += (v[0] * v[0] + v[1] * v[1]) + (v[2] * v[2] + v[3] * v[3]); }
                t += __shfl_xor(t, 16); t += __shfl_xor(t, 32);
                if (fq == 0) (void)__hip_atomic_fetch_add(SA + row0 + ai * HALF + m * 16, (unsigned long long)(t * FXS), __ATOMIC_RELAXED, __HIP_MEMORY_SCOPE_AGENT); }
        asm volatile("s_waitcnt vmcnt(0)" ::: "memory");
        __builtin_amdgcn_s_barrier();
        if (wr == 0 && wc == 0 && fr == 0 && fq == 0) {
            (void)__hip_atomic_fetch_add(cnt + 2 * u.pm, 1u, __ATOMIC_RELAXED, __HIP_MEMORY_SCOPE_AGENT);
            unsigned sp = 0; while (__hip_atomic_load(cnt + 2 * u.pm, __ATOMIC_RELAXED, __HIP_MEMORY_SCOPE_AGENT) < 8u) { __builtin_amdgcn_s_sleep(8); if (++sp > (1u << 20)) break; } }
        __builtin_amdgcn_s_barrier();
        float ry[2][4];
        {   unsigned long long sv[2][4];
#pragma unroll
            for (int ai = 0; ai < 2; ++ai)
#pragma unroll
                for (int m = 0; m < 4; ++m) sv[ai][m] = __hip_atomic_load(SA + row0 + ai * HALF + m * 16, __ATOMIC_RELAXED, __HIP_MEMORY_SCOPE_AGENT);
#pragma unroll
            for (int ai = 0; ai < 2; ++ai)
#pragma unroll
                for (int m = 0; m < 4; ++m) ry[ai][m] = 1.f / sqrtf((float)sv[ai][m] * (1.f / FXS) * (1.f / ND) + EPSN); }
        f32x4 gg[2][2];
#pragma unroll
        for (int bj = 0; bj < 2; ++bj) { gg[bj][0] = *(const f32x4*)(gpost + col0 + bj * HALF); gg[bj][1] = *(const f32x4*)(gpost + col0 + bj * HALF + 4); }
#pragma unroll
        for (int ai = 0; ai < 2; ++ai) {
            u32x4 xw[4][2];
#pragma unroll
            for (int m = 0; m < 4; ++m)
#pragma unroll
                for (int bj = 0; bj < 2; ++bj) xw[m][bj] = *(const u32x4*)(X + (size_t)(row0 + ai * HALF + m * 16) * ND + col0 + bj * HALF);
#pragma unroll
            for (int m = 0; m < 4; ++m) { const int row = row0 + ai * HALF + m * 16; const float r1 = ry[ai][m];
                float t2 = 0.f;
#pragma unroll
                for (int bj = 0; bj < 2; ++bj) { bf16_t* xp = X + (size_t)row * ND + col0 + bj * HALF; const u32x4 x4 = xw[m][bj];
                    f32x4 v0 = acc[ai][bj][m][0] * r1 * gg[bj][0], v1 = acc[ai][bj][m][1] * r1 * gg[bj][1];
                    v0[0] += __uint_as_float(x4.x << 16); v0[1] += __uint_as_float(x4.x & 0xffff0000u); v0[2] += __uint_as_float(x4.y << 16); v0[3] += __uint_as_float(x4.y & 0xffff0000u);
                    v1[0] += __uint_as_float(x4.z << 16); v1[1] += __uint_as_float(x4.z & 0xffff0000u); v1[2] += __uint_as_float(x4.w << 16); v1[3] += __uint_as_float(x4.w & 0xffff0000u);
                    if (FINAL) { float* fo = fout + (size_t)row * ND + col0 + bj * HALF; *(f32x4*)fo = v0; *(f32x4*)(fo + 4) = v1; }
                    else { t2 += ((v0[0] * v0[0] + v0[1] * v0[1]) + (v0[2] * v0[2] + v0[3] * v0[3])) + ((v1[0] * v1[0] + v1[1] * v1[1]) + (v1[2] * v1[2] + v1[3] * v1[3]));
                        u32x4 w; w.x = cvt_pk_bf16(v0[0], v0[1]); w.y = cvt_pk_bf16(v0[2], v0[3]); w.z = cvt_pk_bf16(v1[0], v1[1]); w.w = cvt_pk_bf16(v1[2], v1[3]); *(u32x4*)xp = w; } }
                if (!FINAL) { t2 += __shfl_xor(t2, 16); t2 += __shfl_xor(t2, 32);
                    if (fq == 0) (void)__hip_atomic_fetch_add(SB + row, (unsigned long long)(t2 * FXS), __ATOMIC_RELAXED, __HIP_MEMORY_SCOPE_AGENT); } } }
    }
};

template <class Epi, class Sched, bool ALIGN_EPI = false, bool SP2 = false>
__device__ __forceinline__ void gemm_phase(PG8_LAS unsigned char* lds, const Gemm g, const Sched& S, const Epi& E, int tid) {
    asm volatile("" : "+v"(tid));
    const int wid = __builtin_amdgcn_readfirstlane(tid >> 6), lane = tid & 63, wr = wid >> 2, wc = wid & 3, fr = lane & 15, fq = lane >> 4;
    const int K = g.K, nt = K / BK;
    unsigned voffA[2], voffB[2];
#pragma unroll
    for (int i = 0; i < 2; ++i) { int R, C; stage_rc(tid * 16 + i * 8192, R, C); const int Rb = Epi::PERM ? ((R & ~31) + perm32(R & 31)) : R;
        voffA[i] = (unsigned)(R * K + C) * 2u; voffB[i] = (unsigned)(Rb * K + C) * 2u; }
    const size_t kstep = (size_t)(BK * 2);
    const size_t hstep = (size_t)HALF * K * 2;
    const size_t tstep = 2 * hstep;
    const unsigned ldsw = (unsigned)wid * 1024u;
    const int aoff = lds_byte(wr * 64 + fr, fq * 8), boff = lds_byte(wc * 32 + fr, fq * 8);
#define PG8_SA(b, h) (((b) * 2 + (h)) * HTB)
#define PG8_SB(b, h) ((4 + (b) * 2 + (h)) * HTB)
#define PG8_STAGE(bufoff, gbase, voff) do { _Pragma("unroll") for (int _i = 0; _i < 2; ++_i) \
        __builtin_amdgcn_global_load_lds((const unsigned*)((const char*)(gbase) + (voff)[_i]), (PG8_LAS unsigned*)(lds + (bufoff) + ldsw + _i * 8192), 16, 0, 0); } while (0)
#define PG8_LDA(dst, b, h) do { _Pragma("unroll") for (int m = 0; m < 4; ++m) _Pragma("unroll") for (int k = 0; k < 2; ++k) dst[m][k] = *(const PG8_LAS bf16x8*)(lds + PG8_SA(b, h) + aoff + m * 2048 + k * 1024); } while (0)
#define PG8_LDB(dst, b, h) do { _Pragma("unroll") for (int n = 0; n < 2; ++n) _Pragma("unroll") for (int k = 0; k < 2; ++k) dst[n][k] = *(const PG8_LAS bf16x8*)(lds + PG8_SB(b, h) + boff + n * 2048 + k * 1024); } while (0)
#define PG8_MMA(ai, bj, At, Bt) do { __builtin_amdgcn_s_setprio(1); _Pragma("unroll") for (int m = 0; m < 4; ++m) _Pragma("unroll") for (int n = 0; n < 2; ++n) _Pragma("unroll") for (int k = 0; k < 2; ++k) \
        acc[ai][bj][m][n] = __builtin_amdgcn_mfma_f32_16x16x32_bf16(Bt[n][k], At[m][k], acc[ai][bj][m][n], 0, 0, 0); __builtin_amdgcn_s_setprio(0); } while (0)
#define PG8_WAIT_V(n) asm volatile("s_waitcnt vmcnt(" #n ")" ::: "memory")
#define PG8_WAIT_L(n) asm volatile("s_waitcnt lgkmcnt(" #n ")" ::: "memory")
#define PG8_BAR __builtin_amdgcn_s_barrier()
#define PG8_SCHED __builtin_amdgcn_sched_barrier(0)
    Unit cur, nxt; int ui = 0;
    if (!S.next(0, cur)) return;
    f32x4 acc[2][2][4][2];
#pragma unroll
    for (int a = 0; a < 2; ++a)
#pragma unroll
        for (int b = 0; b < 2; ++b)
#pragma unroll
            for (int m = 0; m < 4; ++m)
#pragma unroll
                for (int n = 0; n < 2; ++n) acc[a][b][m][n] = (f32x4){0.f, 0.f, 0.f, 0.f};
    bf16x8 At[4][2], B0[2][2], B1[2][2];
    const char* cA = (const char*)g.A + (size_t)cur.pm * tstep; const char* cB = (const char*)g.Bt + (size_t)cur.pn * tstep;
    S.a_ready(cur);
    if constexpr (SP2) {
        PG8_STAGE(PG8_SB(0, 0), cB, voffB); PG8_STAGE(PG8_SB(0, 1), cB + hstep, voffB); PG8_STAGE(PG8_SA(0, 0), cA, voffA); PG8_STAGE(PG8_SA(0, 1), cA + hstep, voffA);
        if (wr == 1) PG8_BAR;
        PG8_WAIT_V(2); PG8_BAR;
        PG8_STAGE(PG8_SB(1, 0), cB + kstep, voffB); PG8_STAGE(PG8_SA(1, 0), cA + kstep, voffA); PG8_STAGE(PG8_SB(1, 1), cB + hstep + kstep, voffB);
        PG8_WAIT_V(6); PG8_BAR;
    } else {
        PG8_STAGE(PG8_SB(0, 0), cB, voffB); PG8_STAGE(PG8_SA(0, 0), cA, voffA); PG8_STAGE(PG8_SB(0, 1), cB + hstep, voffB); PG8_STAGE(PG8_SA(0, 1), cA + hstep, voffA);
        if (wr == 1) PG8_BAR;
        PG8_WAIT_V(4); PG8_BAR;
        PG8_STAGE(PG8_SB(1, 0), cB + kstep, voffB); PG8_STAGE(PG8_SA(1, 0), cA + kstep, voffA); PG8_STAGE(PG8_SB(1, 1), cB + hstep + kstep, voffB);
        PG8_WAIT_V(6); PG8_BAR;
    }
    for (;;) {
        const bool has_next = S.next(ui + 1, nxt);
        const char* nA = has_next ? (const char*)g.A + (size_t)nxt.pm * tstep : cA; const char* nB = has_next ? (const char*)g.Bt + (size_t)nxt.pn * tstep : cB;
        for (int t = 0; t < nt; t += 2) {
            const bool last = (t == nt - 2);
            const char* a1 = cA + (size_t)(t + 1) * kstep;
            const char* a2 = last ? nA : cA + (size_t)(t + 2) * kstep; const char* b2 = last ? nB : cB + (size_t)(t + 2) * kstep;
            const char* a3 = a2 + kstep; const char* b3 = b2 + kstep;
            if (last && has_next) S.a_ready(nxt);
            if constexpr (SP2) {
            PG8_LDB(B0, 0, 0); PG8_LDB(B1, 0, 1); PG8_SCHED; PG8_LDA(At, 0, 0); PG8_STAGE(PG8_SA(1, 1), a1 + hstep, voffA);
            PG8_WAIT_V(8); PG8_WAIT_L(0); PG8_BAR; PG8_MMA(0, 0, At, B0); PG8_MMA(0, 1, At, B1); PG8_BAR; PG8_SCHED;
            PG8_LDA(At, 0, 1); PG8_STAGE(PG8_SB(0, 0), b2, voffB); PG8_STAGE(PG8_SB(0, 1), b2 + hstep, voffB); PG8_STAGE(PG8_SA(0, 0), a2, voffA);
            PG8_WAIT_V(8); PG8_WAIT_L(0); PG8_BAR; PG8_MMA(1, 0, At, B0); PG8_MMA(1, 1, At, B1); PG8_BAR; PG8_SCHED;
            PG8_LDB(B0, 1, 0); PG8_LDB(B1, 1, 1); PG8_SCHED; PG8_LDA(At, 1, 0); PG8_STAGE(PG8_SA(0, 1), a2 + hstep, voffA);
            PG8_WAIT_V(8); PG8_WAIT_L(0); PG8_BAR; PG8_MMA(0, 0, At, B0); PG8_MMA(0, 1, At, B1); PG8_BAR; PG8_SCHED;
            PG8_LDA(At, 1, 1); PG8_STAGE(PG8_SB(1, 0), b3, voffB); PG8_STAGE(PG8_SB(1, 1), b3 + hstep, voffB); PG8_STAGE(PG8_SA(1, 0), a3, voffA);
            PG8_WAIT_V(8); PG8_WAIT_L(0); PG8_BAR; PG8_MMA(1, 0, At, B0); PG8_MMA(1, 1, At, B1); PG8_BAR; PG8_SCHED;
            } else {
            PG8_LDB(B0, 0, 0); PG8_SCHED; PG8_LDA(At, 0, 0); PG8_STAGE(PG8_SA(1, 1), a1 + hstep, voffA);
            PG8_WAIT_L(8); PG8_BAR; PG8_WAIT_L(0); PG8_MMA(0, 0, At, B0); PG8_BAR; PG8_SCHED;
            PG8_LDB(B1, 0, 1); PG8_STAGE(PG8_SB(0, 0), b2, voffB);
            PG8_BAR; PG8_WAIT_L(0); PG8_MMA(0, 1, At, B1); PG8_BAR;
            PG8_LDA(At, 0, 1); PG8_STAGE(PG8_SA(0, 0), a2, voffA);
            PG8_BAR; PG8_WAIT_L(0); PG8_MMA(1, 0, At, B0); PG8_BAR; PG8_SCHED;
            PG8_STAGE(PG8_SB(0, 1), b2 + hstep, voffB);
            PG8_WAIT_V(6); PG8_BAR; PG8_MMA(1, 1, At, B1); PG8_BAR;
            PG8_LDB(B0, 1, 0); PG8_SCHED; PG8_LDA(At, 1, 0); PG8_STAGE(PG8_SA(0, 1), a2 + hstep, voffA);
            PG8_WAIT_L(8); PG8_BAR; PG8_WAIT_L(0); PG8_MMA(0, 0, At, B0); PG8_BAR; PG8_SCHED;
            PG8_LDB(B1, 1, 1); PG8_STAGE(PG8_SB(1, 0), b3, voffB);
            PG8_BAR; PG8_WAIT_L(0); PG8_MMA(0, 1, At, B1); PG8_BAR;
            PG8_LDA(At, 1, 1); PG8_STAGE(PG8_SA(1, 0), a3, voffA);
            PG8_BAR; PG8_WAIT_L(0); PG8_MMA(1, 0, At, B0); PG8_BAR; PG8_SCHED;
            PG8_STAGE(PG8_SB(1, 1), b3 + hstep, voffB);
            PG8_WAIT_V(6); PG8_BAR; PG8_MMA(1, 1, At, B1); PG8_BAR;
            }
        }
        if constexpr (ALIGN_EPI) { if (wr == 0) PG8_BAR; }
        if constexpr (!Epi::AFTER_DRAIN) { E(acc, cur, wr, wc, fr, fq); S.done(cur); }
        if (!has_next) break;
#pragma unroll
        for (int a = 0; a < 2; ++a)
#pragma unroll
            for (int b = 0; b < 2; ++b)
#pragma unroll
                for (int m = 0; m < 4; ++m)
#pragma unroll
                    for (int n = 0; n < 2; ++n) acc[a][b][m][n] = (f32x4){0.f, 0.f, 0.f, 0.f};
        cur = nxt; cA = nA; cB = nB; ++ui;
        if constexpr (ALIGN_EPI) { if (wr == 1) PG8_BAR; }
    }
    PG8_WAIT_V(0);
    if constexpr (!ALIGN_EPI) { if (wr == 0) PG8_BAR; }
    PG8_BAR;
    if constexpr (Epi::AFTER_DRAIN) { E.fused(acc, cur, wr, wc, fr, fq, lds, wid, lane); S.done(cur); }
#undef PG8_SA
#undef PG8_SB
#undef PG8_STAGE
#undef PG8_LDA
#undef PG8_LDB
#undef PG8_MMA
#undef PG8_WAIT_V
#undef PG8_WAIT_L
#undef PG8_BAR
#undef PG8_SCHED
}
}


constexpr int NWAVES = 8, NTHR = 512;
constexpr int BATCH = 4, T = 8192, DM = 2048, DEPTH = 2, M = BATCH * T, HD = 64, DFF = 8192, PW = 5920;
constexpr int NQK = 4096, NV = 2048;
constexpr int C_QA = 0, C_KCA = 512, C_VCA = 640, C_KSA = 768, C_KWA = 896, C_QB = 1024, C_KB = 1536, C_QC = 2048, C_KC = 2560, C_QD = 3072, C_KD = 3584;
constexpr int R_VSA = 0, R_VWA = 128, R_VB = 256, R_VC = 768, R_VD = 1280, R_GA = 1792, R_FC = 1816;
constexpr float LOG2E = 1.4426950408889634f;
constexpr float QSCALE = 0.125f * LOG2E;
constexpr float EPS = 1e-6f;

constexpr size_t MiB = 1u << 20;
constexpr size_t WS_CTL = 0, CTL_ZERO_BYTES = 1 * MiB;
constexpr size_t WS_KC = 1 * MiB, WS_VC = 2 * MiB, WS_KMEAN = 3 * MiB, WS_CUM = 4 * MiB;
constexpr size_t WS_RSTD = 3 * MiB;
constexpr size_t WS_VCT = 5 * MiB, WS_KMH = 6 * MiB, WS_KML = 6 * MiB + 512 * 1024;
constexpr size_t WS_SW = 7 * MiB, SW_LAYER = 128 * 1024, SW_W2K = 0, SW_W2V = 32 * 1024, SW_HB = 64 * 1024;
constexpr size_t WS_W = 8 * MiB, W_LAYER = 98 * MiB;
constexpr size_t WO_QK = 0, WO_V = 16 * MiB, WO_OUT = 24 * MiB, WO_UP = 32 * MiB, WO_DOWN = 64 * MiB, WO_W1K = 96 * MiB, WO_W1V = 97 * MiB;
constexpr size_t WS_XN = 204 * MiB, WS_Y = 332 * MiB, WS_QK = 460 * MiB, WS_VT = 716 * MiB, WS_O = 844 * MiB, WS_H = 460 * MiB, WS_END = 972 * MiB;
constexpr size_t WS_VN = WS_Y;
constexpr size_t WS_SEL = WS_VC, WS_PARTO = WS_Y, WS_PARTL = WS_Y + 112 * MiB;
constexpr size_t WS_SSQ = WS_END + 32 * MiB;
constexpr size_t WS_VDF = WS_END;
constexpr int CW_BAR = 4096, CW_KMAX = 8192, CW_Q = 9216, CW_NC = 10240;

constexpr int RING_BYTES = 131072, MISC_OFF = RING_BYTES + 320, LDS_BYTES = 147456;

#define GAS __attribute__((address_space(1)))
#define LAS __attribute__((address_space(3)))
typedef unsigned short bf16;
typedef unsigned v4u __attribute__((ext_vector_type(4)));
typedef unsigned v2u __attribute__((ext_vector_type(2)));
typedef float f32x4 __attribute__((ext_vector_type(4)));
#define LDS_WAIT() asm volatile("s_waitcnt lgkmcnt(0)" ::: "memory")
#define GM_WAIT() asm volatile("s_waitcnt vmcnt(0) lgkmcnt(0)" ::: "memory")
__device__ __forceinline__ unsigned f2bf(float f) { unsigned u = __builtin_bit_cast(unsigned, f); return (u + 0x7fffu + ((u >> 16) & 1u)) >> 16; }
__device__ __forceinline__ unsigned pk2(float lo, float hi) { return f2bf(lo) | (f2bf(hi) << 16); }
__device__ __forceinline__ float bf_lo(unsigned u) { return __uint_as_float(u << 16); }
__device__ __forceinline__ float bf_hi(unsigned u) { return __uint_as_float(u & 0xffff0000u); }
__device__ __forceinline__ float bf2f(bf16 h) { return __uint_as_float(((unsigned)h) << 16); }

#define XB_TMO      128
#define XB_XCNT(j)  (256  + 64 * (j))
#define XB_XSUB(j)  (1280 + 64 * (j))
#define XB_XGEN(j)  (2304 + 64 * (j))
#define XB_TOP      3328
#define XB_TOPGEN   3392
#define XCD_BAR_WORDS 3456
#define XB_SPIN_CAP (1u << 24)

__device__ __forceinline__ unsigned xb_ld(unsigned* p)              { return __hip_atomic_load(p, __ATOMIC_RELAXED, __HIP_MEMORY_SCOPE_AGENT); }
__device__ __forceinline__ unsigned xb_add(unsigned* p, unsigned v) { return __hip_atomic_fetch_add(p, v, __ATOMIC_RELAXED, __HIP_MEMORY_SCOPE_AGENT); }
__device__ __forceinline__ unsigned xb_xcc_id() { return (unsigned)__builtin_amdgcn_s_getreg((3 << 11) | 20) & 0xFu; }
#define XB_SPIN(cond, bar) do { unsigned _sp = 0; while (cond) { __builtin_amdgcn_s_sleep(1); \
    if ((++_sp & 255u) == 0u) { if (xb_ld(&(bar)[XB_TMO])) break; if (_sp > XB_SPIN_CAP) { atomicAdd(&(bar)[XB_TMO], 1u); break; } } } } while (0)

struct XcdBarrier {
    unsigned* bar; unsigned x; int lead;
    volatile LAS unsigned* st;
};

__device__ __forceinline__ XcdBarrier xcd_barrier_post(unsigned* bar, volatile LAS unsigned* st, int lead) {
    XcdBarrier b; b.bar = bar; b.x = xb_xcc_id(); b.st = st; b.lead = lead;
    if (lead) (void)xb_add(&bar[XB_XCNT(b.x)], 1u);
    return b;
}
__device__ __forceinline__ void xcd_barrier_complete(unsigned* bar, unsigned x, unsigned& nloc, unsigned& nx) {
    const unsigned G = gridDim.x * gridDim.y * gridDim.z;
    unsigned sum, cnt, mine, sp = 0u;
    for (;;) {
        sum = 0u; cnt = 0u; mine = 0u;
#pragma unroll
        for (unsigned j = 0; j < 16; ++j) { const unsigned c = xb_ld(&bar[XB_XCNT(j)]); sum += c; cnt += (c > 0u) ? 1u : 0u; mine = (j == x) ? c : mine; }
        if (sum == G) break;
        __builtin_amdgcn_s_sleep(1);
        if ((++sp & 255u) == 0u) { if (xb_ld(&bar[XB_TMO])) break; if (sp > XB_SPIN_CAP) { atomicAdd(&bar[XB_TMO], 1u); break; } }
    }
    nloc = mine > 0u ? mine : 1u; nx = cnt > 0u ? cnt : 1u;
}

__device__ __forceinline__ void xcd_barrier(const XcdBarrier& b) {
    asm volatile("s_waitcnt vmcnt(0)" ::: "memory");
    __syncthreads();
    if (b.lead) {
        unsigned* bar = b.bar;
        __builtin_amdgcn_s_waitcnt(0);
        unsigned nloc = b.st[0], nx = b.st[1];
        if (nloc == 0u) { xcd_barrier_complete(bar, b.x, nloc, nx); b.st[0] = nloc; b.st[1] = nx; }
        const unsigned old = xb_add(&bar[XB_XSUB(b.x)], 1u);
        const unsigned gen = old / nloc;
        if (old + 1u == (gen + 1u) * nloc) {
            __builtin_amdgcn_fence(__ATOMIC_RELEASE, "agent");
            asm volatile("s_waitcnt vmcnt(0)" ::: "memory");
            const unsigned og = xb_add(&bar[XB_TOP], 1u);
            const unsigned tg = og / nx;
            if (og + 1u == (tg + 1u) * nx) xb_add(&bar[XB_TOPGEN], 1u);
            else XB_SPIN(xb_ld(&bar[XB_TOPGEN]) == tg, bar);
            __builtin_amdgcn_fence(__ATOMIC_ACQUIRE, "agent");
            xb_add(&bar[XB_XGEN(b.x)], 1u);
            asm volatile("s_waitcnt vmcnt(0)" ::: "memory");
        } else {
            XB_SPIN(xb_ld(&bar[XB_XGEN(b.x)]) == gen, bar);
            __builtin_amdgcn_fence(__ATOMIC_ACQUIRE, "agent");
            asm volatile("s_waitcnt vmcnt(0)" ::: "memory");
        }
    }
    __syncthreads();
}


struct Args { const float* in[16]; float* out; unsigned char* ws; int ph_lo, ph_hi; };

__device__ __forceinline__ float wave_sum(float v) {
#pragma unroll
    for (int o = 1; o < 64; o <<= 1) v += __shfl_xor(v, o);
    return v;
}
__device__ __forceinline__ float wave_max(float v) {
#pragma unroll
    for (int o = 1; o < 64; o <<= 1) v = fmaxf(v, __shfl_xor(v, o));
    return v;
}
__device__ __forceinline__ unsigned long long wave_max_u64(unsigned long long v) {
#pragma unroll
    for (int o = 1; o < 64; o <<= 1) { unsigned lo = __shfl_xor((unsigned)v, o), hi = __shfl_xor((unsigned)(v >> 32), o); unsigned long long w = ((unsigned long long)hi << 32) | lo; v = w > v ? w : v; }
    return v;
}
__device__ __forceinline__ int t5_bucket(int d) {
    d = d < 0 ? 0 : d;
    if (d < 16) return d;
    const int b = 8 + (31 - __clz(d * d));
    return b < 31 ? b : 31;
}

__device__ __forceinline__ int map_qk(int r, float& sc) {
    sc = 1.f;
    if (r < 512) { sc = QSCALE; return r; }
    if (r < 640) return r;
    if (r < 768) return r;
    if (r < 896) return r;
    if (r < 1024) return 1024 + (r - 896);
    if (r < 1536) { sc = QSCALE; return 1304 + (r - 1024); }
    if (r < 2048) return 1816 + (r - 1536);
    if (r < 2560) { sc = QSCALE; return 2840 + (r - 2048); }
    if (r < 3072) return 3352 + (r - 2560);
    if (r < 3584) { sc = QSCALE; return 4384 + (r - 3072); }
    return 4896 + (r - 3584);
}
__device__ __forceinline__ int map_v(int r, float& sc) {
    sc = 1.f;
    if (r < 128) return 896 + r;
    if (r < 256) return 1152 + (r - 128);
    if (r < 768) return 2328 + (r - 256);
    if (r < 1280) return 3864 + (r - 768);
    if (r < 1792) return 5408 + (r - 1280);
    if (r < 1816) return 1280 + (r - 1792);
    if (r < 1824) return 4376 + (r - 1816);
    return -1;
}
template <int MODE>
__device__ __forceinline__ void transpose_item(const float* W, int K, int N, bf16* WT, int ndst, LAS float* scr, int item, int lane, const float* gain = nullptr) {
    const int nblk = ndst / 32, kb = item / nblk, nb = item % nblk, k0 = 64 * kb, r0 = 32 * nb;
    float sc = 1.f; int src = r0 + (lane & 31);
    if (MODE == 1) src = map_qk(r0 + (lane & 31), sc);
    if (MODE == 2) src = map_v(r0 + (lane & 31), sc);
#pragma unroll 8
    for (int i = 0; i < 32; ++i) { const int kk = 2 * i + (lane >> 5); const float gk = gain ? gain[k0 + kk] : 1.f; scr[kk * 33 + (lane & 31)] = src >= 0 ? W[(size_t)(k0 + kk) * N + src] * (sc * gk) : 0.f; }
    LDS_WAIT(); asm volatile("" ::: "memory");
    const int c = lane & 7;
#pragma unroll
    for (int j = 0; j < 4; ++j) { const int n = (lane >> 3) + 8 * j; const LAS float* s = scr + (8 * c) * 33 + n;
        v4u o; o.x = pk2(s[0 * 33], s[1 * 33]); o.y = pk2(s[2 * 33], s[3 * 33]); o.z = pk2(s[4 * 33], s[5 * 33]); o.w = pk2(s[6 * 33], s[7 * 33]);
        *(GAS v4u*)(WT + (size_t)(r0 + n) * K + k0 + 8 * c) = o; }
    LDS_WAIT(); asm volatile("" ::: "memory");
}

__device__ __forceinline__ void norm_pre_row(const float* xrow, bf16* orow, float* rstd, int lane) {
    const f32x4* xr = (const f32x4*)xrow + lane;
    f32x4 v[8]; float s = 0.f;
#pragma unroll
    for (int j = 0; j < 8; ++j) { v[j] = xr[64 * j]; s += (v[j].x * v[j].x + v[j].y * v[j].y) + (v[j].z * v[j].z + v[j].w * v[j].w); }
    const float r = 1.f / sqrtf(wave_sum(s) * (1.f / DM) + EPS);
    if (lane == 0) *rstd = r;
    unsigned long long* o8 = (unsigned long long*)orow + lane;
#pragma unroll
    for (int j = 0; j < 8; ++j) o8[64 * j] = (unsigned long long)pk2(v[j].x, v[j].y) | ((unsigned long long)pk2(v[j].z, v[j].w) << 32);
}
__device__ __forceinline__ void norm_post_row(const bf16* yrow, bf16* xbrow, const float* g_post, float* fout, float* rstd, int lane) {
    const unsigned long long* y8 = (const unsigned long long*)yrow + lane; unsigned long long* x8 = (unsigned long long*)xbrow + lane;
    const f32x4* gp = (const f32x4*)g_post + lane;
    f32x4 y[8]; float s = 0.f;
#pragma unroll
    for (int j = 0; j < 8; ++j) { const unsigned long long w = y8[64 * j]; const unsigned a = (unsigned)w, b = (unsigned)(w >> 32);
        y[j].x = bf_lo(a); y[j].y = bf_hi(a); y[j].z = bf_lo(b); y[j].w = bf_hi(b);
        s += (y[j].x * y[j].x + y[j].y * y[j].y) + (y[j].z * y[j].z + y[j].w * y[j].w); }
    const float ry = 1.f / sqrtf(wave_sum(s) * (1.f / DM) + EPS);
    float s2 = 0.f;
#pragma unroll
    for (int j = 0; j < 8; ++j) { const unsigned long long w = x8[64 * j]; const unsigned a = (unsigned)w, b = (unsigned)(w >> 32); const f32x4 gg = gp[64 * j];
        y[j].x = bf_lo(a) + y[j].x * ry * gg.x; y[j].y = bf_hi(a) + y[j].y * ry * gg.y; y[j].z = bf_lo(b) + y[j].z * ry * gg.z; y[j].w = bf_hi(b) + y[j].w * ry * gg.w;
        s2 += (y[j].x * y[j].x + y[j].y * y[j].y) + (y[j].z * y[j].z + y[j].w * y[j].w); }
    if (fout) { f32x4* fo = (f32x4*)fout + lane;
#pragma unroll
        for (int j = 0; j < 8; ++j) fo[64 * j] = y[j]; }
    else { const float r2 = 1.f / sqrtf(wave_sum(s2) * (1.f / DM) + EPS); if (lane == 0) *rstd = r2;
#pragma unroll
        for (int j = 0; j < 8; ++j) x8[64 * j] = (unsigned long long)pk2(y[j].x, y[j].y) | ((unsigned long long)pk2(y[j].z, y[j].w) << 32); }
}

__device__ __forceinline__ void load_row64(const bf16* p, float (&v)[64]) {
    const uint4* q = (const uint4*)p;
#pragma unroll
    for (int i = 0; i < 8; ++i) { const uint4 w = q[i];
        v[8 * i + 0] = bf_lo(w.x); v[8 * i + 1] = bf_hi(w.x); v[8 * i + 2] = bf_lo(w.y); v[8 * i + 3] = bf_hi(w.y);
        v[8 * i + 4] = bf_lo(w.z); v[8 * i + 5] = bf_hi(w.z); v[8 * i + 6] = bf_lo(w.w); v[8 * i + 7] = bf_hi(w.w); }
}
__device__ __forceinline__ float dot_row64(const bf16* p, const float (&q)[64]) {
    const uint4* r = (const uint4*)p; float s0 = 0.f, s1 = 0.f;
#pragma unroll
    for (int i = 0; i < 8; ++i) { const uint4 w = r[i];
        s0 += bf_lo(w.x) * q[8 * i + 0]; s1 += bf_hi(w.x) * q[8 * i + 1]; s0 += bf_lo(w.y) * q[8 * i + 2]; s1 += bf_hi(w.y) * q[8 * i + 3];
        s0 += bf_lo(w.z) * q[8 * i + 4]; s1 += bf_hi(w.z) * q[8 * i + 5]; s0 += bf_lo(w.w) * q[8 * i + 6]; s1 += bf_hi(w.w) * q[8 * i + 7]; }
    return s0 + s1;
}
template <class F, class P>
__device__ __forceinline__ float naive_attend(const float (&q)[64], const bf16* Kb, size_t kpitch, const bf16* Vb, size_t vpitch, int nkeys, F f, P pstore, float& l_out, int lane) {
    float m = -INFINITY;
#pragma unroll 1
    for (int j = lane; j < nkeys; j += 64) { int row; float bias; if (f(j, row, bias)) { const float s = dot_row64(Kb + (size_t)row * kpitch, q) + bias; m = fmaxf(m, s); } }
    m = wave_max(m);
    float o[64]; float l = 0.f;
#pragma unroll
    for (int d = 0; d < 64; ++d) o[d] = 0.f;
#pragma unroll 1
    for (int j = lane; j < nkeys; j += 64) { int row; float bias; float p = 0.f;
        if (f(j, row, bias)) { const float s = dot_row64(Kb + (size_t)row * kpitch, q) + bias; p = exp2f(s - m); l += p;
            const uint4* r = (const uint4*)(Vb + (size_t)row * vpitch);
#pragma unroll
            for (int i = 0; i < 8; ++i) { const uint4 w = r[i];
                o[8 * i + 0] += p * bf_lo(w.x); o[8 * i + 1] += p * bf_hi(w.x); o[8 * i + 2] += p * bf_lo(w.y); o[8 * i + 3] += p * bf_hi(w.y);
                o[8 * i + 4] += p * bf_lo(w.z); o[8 * i + 5] += p * bf_hi(w.z); o[8 * i + 6] += p * bf_lo(w.w); o[8 * i + 7] += p * bf_hi(w.w); } }
        if (pstore) pstore[j] = p; }
    l = wave_sum(l);
    float res = 0.f;
#pragma unroll
    for (int d = 0; d < 64; ++d) { const float v = wave_sum(o[d]); if (lane == d) res = v; }
    l_out = l;
    return l > 0.f ? res / l : 0.f;
}
__device__ __forceinline__ float gelu_tanh(float x) { const float u = 0.7978845608028654f * (x + 0.044715f * x * x * x); return 0.5f * x * (1.f + tanhf(u)); }
__device__ __forceinline__ float log_sigmoid(float x) { return x >= 0.f ? -log1pf(expf(-x)) : x - log1pf(expf(x)); }
__device__ __forceinline__ float sigmoidf(float x) { return 1.f / (1.f + expf(-x)); }
__device__ __forceinline__ unsigned ord_f32(float f) { const unsigned u = __float_as_uint(f); return (u & 0x80000000u) ? ~u : (u | 0x80000000u); }


#ifdef NAIVE_ATT
#define NAIVE_PROLOG \
    const int tid = threadIdx.x, lane = tid & 63, wave = tid >> 6; \
    const int gw = blockIdx.x * 4 + wave, NGW = gridDim.x * 4; \
    unsigned char* ws = args.ws; \
    bf16* QK = (bf16*)(ws + WS_QK); bf16* VT = (bf16*)(ws + WS_VT); bf16* OB = (bf16*)(ws + WS_O); bf16* VN = (bf16*)(ws + WS_VN); \
    bf16* KCb = (bf16*)(ws + WS_KC); bf16* VCb = (bf16*)(ws + WS_VC); float* KMEAN = (float*)(ws + WS_KMEAN); float* CUM = (float*)(ws + WS_CUM); \
    const float* relb = args.in[15]; (void)QK; (void)VT; (void)OB; (void)VN; (void)KCb; (void)VCb; (void)KMEAN; (void)CUM; (void)relb; (void)lane; (void)gw; (void)NGW;

__global__ void __launch_bounds__(256) k_naive_vn(Args args) {
    __shared__ unsigned short tile[64][66];
    const bf16* VT = (const bf16*)(args.ws + WS_VT); bf16* VN = (bf16*)(args.ws + WS_VN);
    const int tx = threadIdx.x & 63, ty = threadIdx.x >> 6;
    for (int blk = blockIdx.x; blk < (NV / 64) * (M / 64); blk += gridDim.x) { const int cb = blk % (NV / 64), tb = blk / (NV / 64);
        for (int i = ty; i < 64; i += 4) tile[i][tx] = VT[(size_t)(cb * 64 + i) * M + tb * 64 + tx];
        __syncthreads();
        for (int i = ty; i < 64; i += 4) VN[(size_t)(tb * 64 + i) * NV + cb * 64 + tx] = tile[tx][i];
        __syncthreads(); }
}
__global__ void __launch_bounds__(256) k_naive_pre(Args args, int l) {
    __shared__ __attribute__((aligned(16))) unsigned char lds_raw[4 * 12288];
    LAS unsigned char* L = (LAS unsigned char*)lds_raw;
    NAIVE_PROLOG
            {
                LAS float* blk = (LAS float*)(L + wave * 12288); LAS float* hid = blk + 2048;
                const float* pe = args.in[9] + (size_t)l * 32 * 64;
                for (int u = gw; u < 2 * 8 * 511; u += NGW) {
                    const int which = u / (8 * 511), r = u % (8 * 511), bg = r / 511, c = r % 511, b = bg >> 1, g = bg & 1;
                    const float* w1 = args.in[which ? 12 : 10] + (size_t)l * 2048 * 256; const float* w2 = args.in[which ? 13 : 11] + (size_t)l * 256 * 64;
                    const int col = (which ? C_VCA : C_KCA) + g * 64;
                    for (int k = lane; k < 2048; k += 64) { const int j = k >> 6, d = k & 63; blk[k] = bf2f(QK[(size_t)(b * T + 16 * c + j) * NQK + col + d]) + pe[k]; }
                    LDS_WAIT();
                    float h0 = 0.f, h1 = 0.f, h2 = 0.f, h3 = 0.f;
                    for (int k = 0; k < 2048; ++k) { const float a = blk[k]; const float* wr = w1 + (size_t)k * 256 + lane; h0 += a * wr[0]; h1 += a * wr[64]; h2 += a * wr[128]; h3 += a * wr[192]; }
                    hid[lane] = gelu_tanh(h0); hid[lane + 64] = gelu_tanh(h1); hid[lane + 128] = gelu_tanh(h2); hid[lane + 192] = gelu_tanh(h3);
                    LDS_WAIT();
                    float o = 0.f;
                    for (int n = 0; n < 256; ++n) o += hid[n] * w2[n * 64 + lane];
                    (which ? VCb : KCb)[((size_t)bg * 512 + c) * 64 + lane] = (bf16)f2bf(o);
                    if (which) ((bf16*)(ws + WS_VCT))[((size_t)bg * 64 + lane) * 512 + c] = (bf16)f2bf(o);
                    LDS_WAIT();
                }
            }
            for (int u = gw; u < BATCH * 8 * 32; u += NGW) { const int bh = u >> 5, kb = u & 31, b = bh >> 3, h = bh & 7;
                float s = 0.f; const bf16* p = QK + (size_t)(b * T + kb * 256) * NQK + C_KB + h * 64 + lane;
                for (int i = 0; i < 256; ++i) s += bf2f(p[(size_t)i * NQK]);
                const float km = s * (1.f / 256.f); KMEAN[(size_t)u * 64 + lane] = km; const unsigned hb = f2bf(km); ((bf16*)(ws + WS_KMH))[(size_t)u * 64 + lane] = (bf16)hb; ((bf16*)(ws + WS_KML))[(size_t)u * 64 + lane] = (bf16)f2bf(km - bf_lo(hb)); }
            for (int u = gw; u < 16; u += NGW) { const int bg = u & 7; if (u < 8) KCb[((size_t)bg * 512 + 511) * 64 + lane] = 0; else ((bf16*)(ws + WS_VCT))[((size_t)bg * 64 + lane) * 512 + 511] = 0; }
            for (int u = gw; u < BATCH * 8; u += NGW) { const int b = u >> 3, h = u & 7; const float fb = args.in[14][l * 8 + h];
                const bf16* p = VT + (size_t)(R_FC + h) * M + (size_t)b * T + lane * 128; float s = 0.f;
                for (int i = 0; i < 128; ++i) s += log_sigmoid(bf2f(p[i]) + fb);
                float incl = s;
#pragma unroll
                for (int o = 1; o < 64; o <<= 1) { const float v = __shfl_up(incl, o); if (lane >= o) incl += v; }
                float run = incl - s; float* c = CUM + (size_t)u * T + lane * 128;
                for (int i = 0; i < 128; ++i) { run += log_sigmoid(bf2f(p[i]) + fb); c[i] = run * LOG2E; } }
}
template <int MIX> __global__ void __launch_bounds__(256, 1) k_naive_bcd(Args args, int l) {
    NAIVE_PROLOG
            for (int u = gw; u < BATCH * 8 * T; u += NGW) {
                constexpr int mix = MIX; const int r = u, bh = r / T, t = r % T, b = bh >> 3, h = bh & 7;
                const size_t tok = (size_t)b * T + t;
                float q[64]; float lsum; float res;
                if constexpr (mix == 0) {
                    load_row64(QK + tok * NQK + C_QC + h * 64, q);
                    const float* c = CUM + (size_t)bh * T;
                    res = naive_attend(q, QK + (size_t)b * T * NQK + C_KC + h * 64, NQK, VN + (size_t)b * T * NV + R_VC + h * 64, NV, t + 1,
                        [&](int j, int& row, float& bias) { row = j; bias = -c[j]; return true; }, (LAS float*)nullptr, lsum, lane);
                    OB[tok * DM + 1024 + h * 64 + lane] = (bf16)f2bf(res);
                } else if constexpr (mix == 1) {
                    load_row64(QK + tok * NQK + C_QD + h * 64, q);
                    res = naive_attend(q, QK + (size_t)b * T * NQK + C_KD + h * 64, NQK, VN + (size_t)b * T * NV + R_VD + h * 64, NV, 3 * 129,
                        [&](int j, int& row, float& bias) { const int pat = j / 129, i = j % 129, dil = pat == 0 ? 1 : (pat == 1 ? 4 : 16); const int pos = t - i * dil;
                            row = pos; bias = relb[t5_bucket(i * dil) * 24 + 16 + h] * LOG2E; return pos >= 0; }, (LAS float*)nullptr, lsum, lane);
                    OB[tok * DM + 1536 + h * 64 + lane] = (bf16)f2bf(res);
                } else {
                    load_row64(QK + tok * NQK + C_QB + h * 64, q);
                    const int cur = t >> 8;
                    unsigned long long key = 0ull;
                    if (lane < cur) { const float* km = KMEAN + ((size_t)bh * 32 + lane) * 64; float gsum = 0.f;
#pragma unroll
                        for (int d = 0; d < 64; ++d) gsum += q[d] * km[d];
                        key = ((unsigned long long)ord_f32(gsum) << 32) | (unsigned)(0xffffffffu - (unsigned)lane); }
                    int selb[3];
#pragma unroll
                    for (int rr = 0; rr < 3; ++rr) { const unsigned long long best = wave_max_u64(key);
                        selb[rr] = best ? (int)(0xffffffffu - (unsigned)(best & 0xffffffffull)) : -1; if (key == best) key = 0ull; }
                    res = naive_attend(q, QK + (size_t)b * T * NQK + C_KB + h * 64, NQK, VN + (size_t)b * T * NV + R_VB + h * 64, NV, 4 * 256,
                        [&](int j, int& row, float& bias) { const int seg = j >> 8; int blkk = seg == 0 ? selb[0] : (seg == 1 ? selb[1] : (seg == 2 ? selb[2] : cur));
                            if (blkk < 0) return false; const int pos = blkk * 256 + (j & 255); row = pos; bias = relb[t5_bucket(t - pos) * 24 + 8 + h] * LOG2E; return pos <= t; },
                        (LAS float*)nullptr, lsum, lane);
                    OB[tok * DM + 512 + h * 64 + lane] = (bf16)f2bf(res);
                }
            }
}
__global__ void __launch_bounds__(256, 1) k_naive_nsa(Args args, int l) {
    NAIVE_PROLOG
    float* wsf = (float*)(ws + WS_END) + (size_t)gw * 2048;
            for (int u = gw; u < BATCH * 2 * T; u += NGW) {
                const int bg = u / T, t = u % T, b = bg >> 1, g = bg & 1; const size_t tok = (size_t)b * T + t;
                float* tmp = wsf; float* pcs = wsf + 512; int* sel = (int*)(wsf + 1024);
                for (int c = lane; c < 512; c += 64) pcs[c] = 0.f;
                float* ocs = wsf + 1100;
                for (int r = 0; r < 4; ++r) { const int hd = g * 4 + r; float q[64]; load_row64(QK + tok * NQK + C_QA + hd * 64, q); float lsum;
                    ocs[r * 64 + lane] = naive_attend(q, KCb + (size_t)bg * 512 * 64, 64, VCb + (size_t)bg * 512 * 64, 64, 511,
                        [&](int j, int& row, float& bias) { row = j; const int dc = t - (16 * j + 31); bias = relb[t5_bucket(dc) * 24 + hd] * LOG2E; return dc >= 0; }, tmp, lsum, lane);
                    GM_WAIT();
                    if (lsum > 0.f) { const float inv = 1.f / lsum; for (int c = lane; c < 511; c += 64) pcs[c] += tmp[c] * inv; }
                    GM_WAIT(); }
                const int cur = t >> 6;
                unsigned long long key[2];
#pragma unroll
                for (int e = 0; e < 2; ++e) { const int n = lane + 64 * e; float imp = 0.f;
                    for (int c = 4 * n - 1; c <= 4 * n + 3; ++c) if (c >= 0 && c < 511) imp += pcs[c];
                    const bool forced = (n == 0) || (n == cur) || (n == cur - 1), valid = n <= cur;
                    const float v = forced ? 1e30f : (valid ? imp : -1e30f);
                    key[e] = valid ? (((unsigned long long)ord_f32(v) << 32) | (unsigned)(0xffffffffu - (unsigned)n)) : 0ull; }
                for (int rr = 0; rr < 16; ++rr) { const unsigned long long mine = key[0] > key[1] ? key[0] : key[1]; const unsigned long long best = wave_max_u64(mine);
                    if (lane == 0) sel[rr] = best ? (int)(0xffffffffu - (unsigned)(best & 0xffffffffull)) : -1;
                    if (key[0] == best) key[0] = 0ull; if (key[1] == best) key[1] = 0ull; }
                GM_WAIT();
                for (int r = 0; r < 4; ++r) { const int hd = g * 4 + r; float q[64]; load_row64(QK + tok * NQK + C_QA + hd * 64, q); float lsum;
                    const float os = naive_attend(q, QK + (size_t)b * T * NQK + C_KSA + g * 64, NQK, VN + (size_t)b * T * NV + R_VSA + g * 64, NV, 16 * 64,
                        [&](int j, int& row, float& bias) { const int blkk = sel[j >> 6]; if (blkk < 0) return false; const int pos = blkk * 64 + (j & 63); row = pos;
                            bias = relb[t5_bucket(t - pos) * 24 + hd] * LOG2E; return pos <= t; }, (float*)nullptr, lsum, lane);
                    const float ow = naive_attend(q, QK + (size_t)b * T * NQK + C_KWA + g * 64, NQK, VN + (size_t)b * T * NV + R_VWA + g * 64, NV, 512,
                        [&](int j, int& row, float& bias) { const int pos = t - j; row = pos; bias = relb[t5_bucket(j) * 24 + hd] * LOG2E; return pos >= 0; }, (float*)nullptr, lsum, lane);
                    const float g0 = sigmoidf(bf2f(VT[(size_t)(R_GA + 0 * 8 + hd) * M + tok])), g1 = sigmoidf(bf2f(VT[(size_t)(R_GA + 1 * 8 + hd) * M + tok])), g2 = sigmoidf(bf2f(VT[(size_t)(R_GA + 2 * 8 + hd) * M + tok]));
                    OB[tok * DM + hd * 64 + lane] = (bf16)f2bf(g0 * ocs[r * 64 + lane] + g1 * os + g2 * ow); }
                GM_WAIT();
            }
}
#endif


typedef short bf16x8 __attribute__((ext_vector_type(8)));
#define MFMA16(a, b, c) __builtin_amdgcn_mfma_f32_16x16x32_bf16((a), (b), (c), 0, 0, 0)
__device__ __forceinline__ bf16x8 ld16(const bf16* p) { return *(const bf16x8*)p; }
__device__ __forceinline__ float rg_max(float v) {
    v = fmaxf(v, __shfl_xor(v, 16));
    auto b = __builtin_amdgcn_permlane32_swap(__float_as_uint(v), __float_as_uint(v), false, false);
    return fmaxf(__uint_as_float(b[0]), __uint_as_float(b[1]));
}
__device__ __forceinline__ float rg_sum(float v) {
    v += __shfl_xor(v, 16);
    auto b = __builtin_amdgcn_permlane32_swap(__float_as_uint(v), __float_as_uint(v), false, false);
    return __uint_as_float(b[0]) + __uint_as_float(b[1]);
}
__device__ __forceinline__ unsigned rg_max_u32(unsigned v) {
    const unsigned w = __shfl_xor(v, 16); v = w > v ? w : v;
    auto b = __builtin_amdgcn_permlane32_swap(v, v, false, false);
    return b[0] > b[1] ? b[0] : b[1];
}
__device__ __forceinline__ unsigned cvt_pk(float lo, float hi) { return pg8::cvt_pk_bf16(lo, hi); }
typedef unsigned u32x4t __attribute__((ext_vector_type(4)));

struct AttSt { f32x4 ot[4]; f32x4 lv; float m, l; };
__device__ __forceinline__ void att_init(AttSt& s) {
#pragma unroll
    for (int i = 0; i < 4; ++i) s.ot[i] = (f32x4){0.f, 0.f, 0.f, 0.f};
    s.lv = (f32x4){0.f, 0.f, 0.f, 0.f}; s.m = -INFINITY; s.l = 0.f;
}
__device__ __forceinline__ bf16x8 att_softmax(AttSt& st, f32x4 a0, f32x4 a1) {
    float mx = fmaxf(fmaxf(fmaxf(a0[0], a0[1]), fmaxf(a0[2], a0[3])), fmaxf(fmaxf(a1[0], a1[1]), fmaxf(a1[2], a1[3])));
    mx = rg_max(mx);
    const float mnew = fmaxf(st.m, mx);
    const float ms = (mnew == -INFINITY) ? 0.f : mnew;
    const float alpha = exp2f(st.m - ms);
    st.m = mnew;
    float p[8];
#pragma unroll
    for (int i = 0; i < 4; ++i) { p[i] = __builtin_amdgcn_exp2f(a0[i] - ms); p[4 + i] = __builtin_amdgcn_exp2f(a1[i] - ms); }
    st.l = st.l * alpha + (((p[0] + p[1]) + (p[2] + p[3])) + ((p[4] + p[5]) + (p[6] + p[7])));
#pragma unroll
    for (int i = 0; i < 4; ++i) st.ot[i] = st.ot[i] * alpha;
    u32x4t w; w.x = cvt_pk(p[0], p[1]); w.y = cvt_pk(p[2], p[3]); w.z = cvt_pk(p[4], p[5]); w.w = cvt_pk(p[6], p[7]);
    return __builtin_bit_cast(bf16x8, w);
}
__device__ __forceinline__ bf16x8 att_softmax_ref(AttSt& st, f32x4 a0, f32x4 a1) {
    float p[8];
#pragma unroll
    for (int i = 0; i < 4; ++i) { p[i] = __builtin_amdgcn_exp2f(a0[i]); p[4 + i] = __builtin_amdgcn_exp2f(a1[i]); }
    st.l += (((p[0] + p[1]) + (p[2] + p[3])) + ((p[4] + p[5]) + (p[6] + p[7])));
    u32x4t w; w.x = cvt_pk(p[0], p[1]); w.y = cvt_pk(p[2], p[3]); w.z = cvt_pk(p[4], p[5]); w.w = cvt_pk(p[6], p[7]);
    return __builtin_bit_cast(bf16x8, w);
}
__device__ __forceinline__ float q_norm(const bf16x8 (&q)[2]) {
    float s = 0.f;
#pragma unroll
    for (int k = 0; k < 2; ++k) { const u32x4t w = __builtin_bit_cast(u32x4t, q[k]);
        s += bf_lo(w.x) * bf_lo(w.x) + bf_hi(w.x) * bf_hi(w.x) + bf_lo(w.y) * bf_lo(w.y) + bf_hi(w.y) * bf_hi(w.y) + bf_lo(w.z) * bf_lo(w.z) + bf_hi(w.z) * bf_hi(w.z) + bf_lo(w.w) * bf_lo(w.w) + bf_hi(w.w) * bf_hi(w.w); }
    return sqrtf(rg_sum(s));
}
__device__ __forceinline__ void att_finish(AttSt& st, float gate) {
    const float lt = rg_sum(st.l);
    const float sc = lt > 0.f ? gate / lt : 0.f;
#pragma unroll
    for (int i = 0; i < 4; ++i) st.ot[i] = st.ot[i] * sc;
}
struct KVFrag { bf16x8 k[2][2]; bf16x8 v[4]; };
__device__ __forceinline__ void kv_load(KVFrag& f, const bf16* Kb, size_t kpitch, const bf16* Vb, size_t vpitch, int k0, int n, int rg) {
    const bf16* kr = Kb + (size_t)(k0 + 8 * (n >> 2) + (n & 3)) * kpitch + 8 * rg;
#pragma unroll
    for (int e = 0; e < 2; ++e)
#pragma unroll
        for (int s = 0; s < 2; ++s) f.k[e][s] = ld16(kr + (size_t)(4 * e) * kpitch + 32 * s);
    const bf16* vr = Vb + (size_t)n * vpitch + k0 + 8 * rg;
#pragma unroll
    for (int dt = 0; dt < 4; ++dt) f.v[dt] = ld16(vr + (size_t)(16 * dt) * vpitch);
}
__device__ __forceinline__ void att_qk(f32x4 (&acc)[2], const KVFrag& f, const bf16x8 (&q)[2], f32x4 i0, f32x4 i1) {
    acc[0] = MFMA16(f.k[0][0], q[0], i0); acc[1] = MFMA16(f.k[1][0], q[0], i1);
    acc[0] = MFMA16(f.k[0][1], q[1], acc[0]); acc[1] = MFMA16(f.k[1][1], q[1], acc[1]);
}
__device__ __forceinline__ void att_pv(AttSt& st, const KVFrag& f, bf16x8 p) {
#pragma unroll
    for (int dt = 0; dt < 4; ++dt) st.ot[dt] = MFMA16(f.v[dt], p, st.ot[dt]);
}
__device__ __forceinline__ bf16x8 att_softmax_refm(f32x4 a0, f32x4 a1) {
    float p[8];
#pragma unroll
    for (int i = 0; i < 4; ++i) { p[i] = __builtin_amdgcn_exp2f(a0[i]); p[4 + i] = __builtin_amdgcn_exp2f(a1[i]); }
    u32x4t w; w.x = cvt_pk(p[0], p[1]); w.y = cvt_pk(p[2], p[3]); w.z = cvt_pk(p[4], p[5]); w.w = cvt_pk(p[6], p[7]);
    return __builtin_bit_cast(bf16x8, w);
}
__device__ __forceinline__ void att_pv_l(AttSt& st, const KVFrag& f, bf16x8 p) {
    const u32x4t o4 = {0x3F803F80u, 0x3F803F80u, 0x3F803F80u, 0x3F803F80u};
#pragma unroll
    for (int dt = 0; dt < 4; ++dt) st.ot[dt] = MFMA16(f.v[dt], p, st.ot[dt]);
    st.lv = MFMA16(__builtin_bit_cast(bf16x8, o4), p, st.lv);
}
__device__ __forceinline__ void att_finish_l(AttSt& st, float gate) {
    const float lt = st.lv[0];
    const float sc = lt > 0.f ? gate / lt : 0.f;
#pragma unroll
    for (int i = 0; i < 4; ++i) st.ot[i] = st.ot[i] * sc;
}
__device__ __forceinline__ int t5b(int d) { if (d < 16) return d < 0 ? 0 : d; const int b = 8 + (31 - __clz(d * d)); return b < 31 ? b : 31; }

template <int MIX>
__device__ __forceinline__ void att_dense_unit(int b, int h, int qb, int lane, const bf16* QK, const bf16* VT, const float* CUM, const bf16* KMH, const bf16* KML, bf16* OB, const LAS float* tabs, const unsigned* KMX) {
    asm volatile("" : "+v"(lane));
    const int n = lane & 15, rg = lane >> 4, q0 = qb * 32;
    constexpr int CQ = MIX == 0 ? C_QC : (MIX == 1 ? C_QD : C_QB), CK = MIX == 0 ? C_KC : (MIX == 1 ? C_KD : C_KB), RV = MIX == 0 ? R_VC : (MIX == 1 ? R_VD : R_VB);
    constexpr int OC = MIX == 0 ? 1024 : (MIX == 1 ? 1536 : 512), TH = MIX == 1 ? 16 : 8;
    const LAS float* tab = tabs + (TH + h) * 32;
    const bf16* Kb = QK + (size_t)b * T * NQK + CK + h * 64; const bf16* Vb = VT + (size_t)(RV + h * 64) * M + (size_t)b * T;
    const float* cum = CUM + (size_t)(b * 8 + h) * T;
    bf16x8 qf[2][2];
#pragma unroll
    for (int ct = 0; ct < 2; ++ct)
#pragma unroll
        for (int s = 0; s < 2; ++s) qf[ct][s] = ld16(QK + (size_t)(b * T + q0 + 16 * ct + n) * NQK + CQ + h * 64 + 32 * s + 8 * rg);
    const int qpos0 = q0 + n, qpos1 = q0 + 16 + n;
    AttSt st[2]; att_init(st[0]); att_init(st[1]);
    const float kmx = sqrtf(__uint_as_float(KMX[b * 28 + (MIX == 0 ? 8 : (MIX == 1 ? 16 : 0)) + h])) * 1.0001f;
    float nref[2], cq[2];
#pragma unroll
    for (int ct = 0; ct < 2; ++ct) { nref[ct] = -(q_norm(qf[ct]) * kmx + (MIX == 0 ? 0.f : tabs[768 + TH + h]) + (MIX == 1 ? 1.585f : 0.f)); cq[ct] = MIX == 0 ? cum[q0 + 16 * ct + n] : 0.f; }
    unsigned selm[2] = {0u, 0u}; unsigned wmask = 0u;
    const int own = qb >> 3;
    if (MIX == 2) {
        const bf16* kh = KMH + (size_t)(b * 8 + h) * 32 * 64; const bf16* kl = KML + (size_t)(b * 8 + h) * 32 * 64;
        bf16x8 gh[2][2], gl[2][2];
        const size_t ro = (size_t)(8 * (n >> 2) + (n & 3)) * 64 + 8 * rg;
#pragma unroll
        for (int e = 0; e < 2; ++e)
#pragma unroll
            for (int s = 0; s < 2; ++s) { gh[e][s] = ld16(kh + ro + (size_t)(4 * e) * 64 + 32 * s); gl[e][s] = ld16(kl + ro + (size_t)(4 * e) * 64 + 32 * s); }
#pragma unroll
        for (int ct = 0; ct < 2; ++ct) {
            f32x4 a0 = {0.f, 0.f, 0.f, 0.f}, a1 = {0.f, 0.f, 0.f, 0.f};
#pragma unroll
            for (int s = 0; s < 2; ++s) { a0 = MFMA16(gh[0][s], qf[ct][s], a0); a1 = MFMA16(gh[1][s], qf[ct][s], a1); a0 = MFMA16(gl[0][s], qf[ct][s], a0); a1 = MFMA16(gl[1][s], qf[ct][s], a1); }
            unsigned key[8];
#pragma unroll
            for (int i = 0; i < 8; ++i) { const int kb = 8 * rg + i; const float g = i < 4 ? a0[i] : a1[i - 4]; key[i] = kb < own ? ((ord_f32(g) & ~31u) | (unsigned)(31 - kb)) : 0u; }
#pragma unroll
            for (int r = 0; r < 3; ++r) { unsigned mx = key[0];
#pragma unroll
                for (int i = 1; i < 8; ++i) mx = key[i] > mx ? key[i] : mx;
                mx = rg_max_u32(mx);
                if (mx) selm[ct] |= 1u << (31 - (mx & 31u));
#pragma unroll
                for (int i = 0; i < 8; ++i) key[i] = key[i] == mx ? 0u : key[i]; }
        }
        unsigned um = selm[0] | selm[1];
#pragma unroll
        for (int o = 1; o < 64; o <<= 1) um |= __shfl_xor(um, o);
        wmask = um | (1u << own);
    }
    int ht, ht_last;
    if (MIX == 0) { ht = 0; ht_last = qb; } else if (MIX == 1) { ht = qb - 64 < 0 ? 0 : qb - 64; ht_last = qb; } else { ht = 8 * (__ffs(wmask) - 1); ht_last = qb; }
    auto next_ht = [&](int c) -> int {
        if (c >= ht_last) return -1;
        if (MIX != 2) return c + 1;
        if ((c & 7) != 7) return c + 1;
        const unsigned rem = wmask >> ((c >> 3) + 1); if (!rem) return -1;
        return 8 * ((c >> 3) + 1 + (__ffs(rem) - 1)); };
    auto step = [&](const KVFrag& f, f32x4 c0, f32x4 c1, int hc) {
        const int k0 = 32 * hc + 8 * rg;
#pragma unroll
        for (int ct = 0; ct < 2; ++ct) {
            const float base = nref[ct] + cq[ct];
            const f32x4 i0 = MIX == 0 ? (f32x4){base, base, base, base} - c0 : (f32x4){base, base, base, base}, i1 = MIX == 0 ? (f32x4){base, base, base, base} - c1 : i0;
            f32x4 acc[2]; att_qk(acc, f, qf[ct], i0, i1);
            const int qp = ct ? qpos1 : qpos0;
            if (MIX == 0) {
                if (hc == qb) {
#pragma unroll
                    for (int i = 0; i < 4; ++i) { if (k0 + i > qp) acc[0][i] = -INFINITY; if (k0 + 4 + i > qp) acc[1][i] = -INFINITY; } }
            } else if (MIX == 1) {
#pragma unroll
                for (int i = 0; i < 8; ++i) { const int d = qp - (k0 + i);
                    const int c1n = d <= 128 ? 1 : 0, c2n = ((d & 3) == 0 && d <= 512) ? 1 : 0, c3n = ((d & 15) == 0 && d <= 2048) ? 1 : 0; const int mult = c1n + c2n + c3n;
                    const float add = (d >= 0 && mult > 0) ? tab[t5b(d)] + (mult == 1 ? 0.f : (mult == 2 ? 1.f : 1.5849625007211562f)) : -INFINITY;
                    if (i < 4) acc[0][i] += add; else acc[1][i - 4] += add; }
            } else {
                const bool allowed = ((hc >> 3) == own) || ((selm[ct] >> (hc >> 3)) & 1u);
#pragma unroll
                for (int i = 0; i < 8; ++i) { const int d = qp - (k0 + i); const float add = (allowed && d >= 0) ? tab[t5b(d)] : -INFINITY;
                    if (i < 4) acc[0][i] += add; else acc[1][i - 4] += add; }
            }
            const bf16x8 p = att_softmax_ref(st[ct], acc[0], acc[1]);
            att_pv(st[ct], f, p);
        } };
    auto cinit = [&](f32x4& c0, f32x4& c1, int hc) {
        if (MIX == 0) { c0 = *(const f32x4*)(cum + 32 * hc + 8 * rg); c1 = *(const f32x4*)(cum + 32 * hc + 8 * rg + 4); }
        else { c0 = (f32x4){0.f, 0.f, 0.f, 0.f}; c1 = c0; } };
    KVFrag fa, fb; f32x4 ca0, ca1, cb0, cb1;
    cinit(ca0, ca1, ht); kv_load(fa, Kb, NQK, Vb, M, 32 * ht, n, rg);
    for (;;) {
        int nx = next_ht(ht); { const int pf = nx < 0 ? ht : nx; cinit(cb0, cb1, pf); kv_load(fb, Kb, NQK, Vb, M, 32 * pf, n, rg); }
        step(fa, ca0, ca1, ht);
        if (nx < 0) break;
        ht = nx; nx = next_ht(ht); { const int pf = nx < 0 ? ht : nx; cinit(ca0, ca1, pf); kv_load(fa, Kb, NQK, Vb, M, 32 * pf, n, rg); }
        step(fb, cb0, cb1, ht);
        if (nx < 0) break;
        ht = nx;
    }
#pragma unroll
    for (int ct = 0; ct < 2; ++ct) { att_finish(st[ct], 1.f);
        bf16* orow = OB + (size_t)(b * T + q0 + 16 * ct + n) * DM + OC + h * 64 + 4 * rg;
#pragma unroll
        for (int dt = 0; dt < 4; ++dt) { v2u w; w.x = cvt_pk(st[ct].ot[dt][0], st[ct].ot[dt][1]); w.y = cvt_pk(st[ct].ot[dt][2], st[ct].ot[dt][3]); *(v2u*)(orow + 16 * dt) = w; } }
}


constexpr int COOP_BUF = 8192, COOP_OFF = 8192, COOP_MASK_OFF = 4096, COOP_LUT_OFF = 24576, COOP_LUT_PAD = 288, COOP_LUT_N = 3296;
template <int MIX>
__device__ __forceinline__ void att_coop_unit(LAS unsigned char* L, int b, int h, int u256, int tid, const bf16* QK, const bf16* VT, const float* CUM, const bf16* KMH, const bf16* KML, bf16* OB, const LAS float* tabs, const unsigned* KMX, const bf16* VDF = nullptr, const bf16* PARTO = nullptr, const float* PARTL = nullptr) {
    asm volatile("" : "+v"(tid));
    const int lane = tid & 63, wave = __builtin_amdgcn_readfirstlane(tid >> 6), n = lane & 15, rg = lane >> 4, qb = 8 * u256 + wave, q0 = qb * 32;
    constexpr int CQ = MIX == 0 ? C_QC : (MIX == 1 ? C_QD : C_QB), CK = MIX == 0 ? C_KC : (MIX == 1 ? C_KD : C_KB), RV = MIX == 0 ? R_VC : (MIX == 1 ? R_VD : R_VB);
    constexpr int OC = MIX == 0 ? 1024 : (MIX == 1 ? 1536 : 512), TH = MIX == 1 ? 16 : 8;
    const LAS float* tab = tabs + (TH + h) * 32;
    const char* Kb = (const char*)(QK + (size_t)b * T * NQK + CK + h * 64); const char* Vb = (const char*)(VT + (size_t)(RV + h * 64) * M + (size_t)b * T);
    const float* cum = CUM + (size_t)(b * 8 + h) * T;
    bf16x8 qf[2][2];
#pragma unroll
    for (int ct = 0; ct < 2; ++ct)
#pragma unroll
        for (int s = 0; s < 2; ++s) qf[ct][s] = ld16(QK + (size_t)(b * T + (MIX == 1 ? 256 * u256 + 2 * wave + ct + 16 * n : q0 + 16 * ct + n)) * NQK + CQ + h * 64 + 32 * s + 8 * rg);
    const int qpos0 = MIX == 1 ? 256 * u256 + 2 * wave + 16 * n : q0 + n, qpos1 = MIX == 1 ? 256 * u256 + 2 * wave + 1 + 16 * n : q0 + 16 + n;
    AttSt st[2]; att_init(st[0]); att_init(st[1]);
    const float kmx = sqrtf(__uint_as_float(KMX[b * 28 + (MIX == 0 ? 8 : (MIX == 1 ? 16 : 0)) + h])) * 1.0001f;
    float nref[2], cq[2];
#pragma unroll
    for (int ct = 0; ct < 2; ++ct) { nref[ct] = -(q_norm(qf[ct]) * kmx + (MIX == 0 ? 0.f : tabs[768 + TH + h]) + (MIX == 1 ? 1.585f : 0.f)); cq[ct] = MIX == 0 ? cum[q0 + 16 * ct + n] : 0.f; }
    unsigned selm[2] = {0u, 0u}; unsigned wmask = 0u, umask = 0u;
    const int own = u256;
    LAS unsigned* mword = (LAS unsigned*)(L + COOP_MASK_OFF);
    if (MIX == 3) { wmask = 1u << own; umask = wmask; }
    if (MIX == 2) {
        const bf16* kh = KMH + (size_t)(b * 8 + h) * 32 * 64; const bf16* kl = KML + (size_t)(b * 8 + h) * 32 * 64;
        bf16x8 gh[2][2], gl[2][2];
        const size_t ro = (size_t)(8 * (n >> 2) + (n & 3)) * 64 + 8 * rg;
#pragma unroll
        for (int e = 0; e < 2; ++e)
#pragma unroll
            for (int s = 0; s < 2; ++s) { gh[e][s] = ld16(kh + ro + (size_t)(4 * e) * 64 + 32 * s); gl[e][s] = ld16(kl + ro + (size_t)(4 * e) * 64 + 32 * s); }
#pragma unroll
        for (int ct = 0; ct < 2; ++ct) {
            f32x4 a0 = {0.f, 0.f, 0.f, 0.f}, a1 = {0.f, 0.f, 0.f, 0.f};
#pragma unroll
            for (int s = 0; s < 2; ++s) { a0 = MFMA16(gh[0][s], qf[ct][s], a0); a1 = MFMA16(gh[1][s], qf[ct][s], a1); a0 = MFMA16(gl[0][s], qf[ct][s], a0); a1 = MFMA16(gl[1][s], qf[ct][s], a1); }
            unsigned key[8];
#pragma unroll
            for (int i = 0; i < 8; ++i) { const int kb = 8 * rg + i; const float g = i < 4 ? a0[i] : a1[i - 4]; key[i] = kb < own ? ((ord_f32(g) & ~31u) | (unsigned)(31 - kb)) : 0u; }
#pragma unroll
            for (int r = 0; r < 3; ++r) { unsigned mx = key[0];
#pragma unroll
                for (int i = 1; i < 8; ++i) mx = key[i] > mx ? key[i] : mx;
                mx = rg_max_u32(mx);
                if (mx) selm[ct] |= 1u << (31 - (mx & 31u));
#pragma unroll
                for (int i = 0; i < 8; ++i) key[i] = key[i] == mx ? 0u : key[i]; }
        }
        unsigned um = selm[0] | selm[1];
#pragma unroll
        for (int o = 1; o < 64; o <<= 1) um |= __shfl_xor(um, o);
        wmask = um | (1u << own);
        if (tid == 0) *mword = 0u;
        __syncthreads();
        if (lane == 0) __hip_atomic_fetch_or(mword, wmask, __ATOMIC_RELAXED, __HIP_MEMORY_SCOPE_WORKGROUP);
        __syncthreads();
        umask = *mword;
    }
    LAS float* lut = (LAS float*)(L + COOP_LUT_OFF);
    if (MIX != 0) {
        for (int i = tid; i < COOP_LUT_N; i += NTHR) { const int d = i - COOP_LUT_PAD; float v = -INFINITY;
            if (d >= 0) { if (MIX >= 2) v = tab[t5b(d)];
                else { const int mult = (d <= 128 ? 1 : 0) + (((d & 3) == 0 && d <= 512) ? 1 : 0) + (((d & 15) == 0 && d <= 512) ? 1 : 0); if (mult > 0) v = tab[t5b(d)] + (mult == 1 ? 0.f : (mult == 2 ? 1.f : 1.5849625007211562f)); } }
            lut[i] = v; }
    }
    const int ht_last = 8 * u256 + 7;
    int ht = MIX == 0 ? 0 : (MIX == 1 ? (8 * u256 - 16 < 0 ? 0 : 8 * u256 - 16) : 8 * (__ffs(umask) - 1));
    auto next_ht = [&](int c) -> int {
        if (c >= ht_last) return -1;
        if (MIX < 2) return c + 1;
        if ((c & 7) != 7) return c + 1;
        const unsigned rem = umask >> ((c >> 3) + 1); if (!rem) return -1;
        return 8 * ((c >> 3) + 1 + (__ffs(rem) - 1)); };
    const bool isk = tid < 256; const int t2 = tid & 255;
    const int lrow = isk ? (t2 >> 3) : (t2 >> 2), lch = isk ? (t2 & 7) : (t2 & 3);
    const size_t gofs = isk ? (size_t)lrow * (NQK * 2) + 16 * lch : (size_t)lrow * ((size_t)M * 2) + 16 * lch;
    const size_t gstep = isk ? (size_t)32 * NQK * 2 : (size_t)64;
    const char* gbase = (isk ? Kb : Vb) + gofs;
    const int lofs = isk ? 128 * lrow + 16 * (lch ^ (((lrow >> 4) & 1) * 5 + ((lrow >> 1) & 1) * 2)) : 4096 + 64 * lrow + 16 * (lch ^ (3 * ((lrow >> 3) & 1)));
    LAS unsigned char* tb = L + COOP_OFF;
    int kro[2][2], vro[4];
#pragma unroll
    for (int e = 0; e < 2; ++e) { const int rho = 8 * (n >> 2) + 4 * e + (n & 3); const int fk = ((rho >> 4) & 1) * 5 + ((rho >> 1) & 1) * 2;
#pragma unroll
        for (int s = 0; s < 2; ++s) kro[e][s] = 128 * rho + 16 * ((4 * s + rg) ^ fk); }
#pragma unroll
    for (int dt = 0; dt < 4; ++dt) { const int d = 16 * dt + n; vro[dt] = 4096 + 64 * d + 16 * (rg ^ (3 * ((d >> 3) & 1))); }
    auto step = [&](const LAS unsigned char* buf, f32x4 c0, f32x4 c1, int hc) {
        KVFrag f;
#pragma unroll
        for (int e = 0; e < 2; ++e)
#pragma unroll
            for (int s = 0; s < 2; ++s) f.k[e][s] = *(const LAS bf16x8*)(buf + kro[e][s]);
#pragma unroll
        for (int dt = 0; dt < 4; ++dt) f.v[dt] = *(const LAS bf16x8*)(buf + vro[dt]);
        const int k0 = 32 * hc + 8 * rg;
#pragma unroll
        for (int ct = 0; ct < 2; ++ct) {
            const float base = nref[ct] + cq[ct];
            const f32x4 i0 = MIX == 0 ? (f32x4){base, base, base, base} - c0 : (f32x4){base, base, base, base}, i1 = MIX == 0 ? (f32x4){base, base, base, base} - c1 : i0;
            f32x4 acc[2]; att_qk(acc, f, qf[ct], i0, i1);
            const int qp = ct ? qpos1 : qpos0;
            if (MIX == 0) {
                if (hc == qb) {
#pragma unroll
                    for (int i = 0; i < 4; ++i) { if (k0 + i > qp) acc[0][i] = -INFINITY; if (k0 + 4 + i > qp) acc[1][i] = -INFINITY; } }
            } else {
                const int dl = qp - k0;
                const int dlo_ = (q0 + 16 * ct) - (32 * hc + 31);
                if (MIX >= 2 && dlo_ >= 0 && t5b(dlo_) == t5b(dlo_ + 46)) {
                    const float add = (MIX == 3 || ((hc >> 3) == own) || ((selm[ct] >> (hc >> 3)) & 1u)) ? tab[t5b(dlo_)] : -INFINITY;
#pragma unroll
                    for (int i = 0; i < 4; ++i) { acc[0][i] += add; acc[1][i] += add; }
                } else {
                    const bool allowed = MIX == 1 || MIX == 3 || ((hc >> 3) == own) || ((selm[ct] >> (hc >> 3)) & 1u);
                    const LAS float* lp = lut + COOP_LUT_PAD + dl - 7;
                    float lv[8];
#pragma unroll
                    for (int i = 0; i < 8; ++i) lv[i] = lp[7 - i];
#pragma unroll
                    for (int i = 0; i < 8; ++i) { const float add = allowed ? lv[i] : -INFINITY; if (i < 4) acc[0][i] += add; else acc[1][i - 4] += add; }
                }
            }
            const bf16x8 p = att_softmax_refm(acc[0], acc[1]);
            att_pv_l(st[ct], f, p);
        } };
    auto need = [&](int hc) -> bool { if (MIX == 0) return hc <= qb; if (MIX == 1) return true; return ((hc >> 3) == own) ? hc <= qb : (MIX == 2 && ((wmask >> (hc >> 3)) & 1u) != 0u); };
    auto cinit = [&](f32x4& c0, f32x4& c1, int hc) {
        if (MIX == 0) { c0 = *(const f32x4*)(cum + 32 * hc + 8 * rg); c1 = *(const f32x4*)(cum + 32 * hc + 8 * rg + 4); }
        else { c0 = (f32x4){0.f, 0.f, 0.f, 0.f}; c1 = c0; } };
    f32x4 ca0, ca1, cb0, cb1;
    {   v4u r = *(const v4u*)(gbase + (size_t)ht * gstep); cinit(ca0, ca1, ht);
        *(LAS v4u*)(tb + lofs) = r; }
    __syncthreads();
    int par = 0;
    for (;;) {
        const int nx = next_ht(ht); const int pf = nx < 0 ? ht : nx;
        const v4u r = *(const v4u*)(gbase + (size_t)pf * gstep);
        if (par == 0) { cinit(cb0, cb1, pf); if (need(ht)) step(tb, ca0, ca1, ht); }
        else { cinit(ca0, ca1, pf); if (need(ht)) step(tb + COOP_BUF, cb0, cb1, ht); }
        *(LAS v4u*)(tb + (par ? 0 : COOP_BUF) + lofs) = r;
        __syncthreads();
        if (nx < 0) break;
        ht = nx; par ^= 1;
    }
    if (MIX == 1) {
        const int Qf = 16 * u256;
#pragma unroll
        for (int ct = 0; ct < 2; ++ct) { const int r = 2 * wave + ct;
            const bf16* Kr = QK + (size_t)(b * T + r) * NQK + CK + h * 64;
            const bf16* Vr = VDF + ((size_t)(b * 512 + h * 64) * 16 + r) * 512;
            const float base = nref[ct]; const f32x4 i0 = {base, base, base, base};
            for (int sft = 0; sft < 4; ++sft) { const int k0f = Qf - 128 + 32 * sft; if (k0f + 31 < 0) continue;
                KVFrag f;
                { const int kr0 = k0f + 8 * (n >> 2) + (n & 3);
#pragma unroll
                  for (int e = 0; e < 2; ++e) { const int kr = kr0 + 4 * e < 0 ? 0 : kr0 + 4 * e;
#pragma unroll
                      for (int s2 = 0; s2 < 2; ++s2) f.k[e][s2] = ld16(Kr + (size_t)(16 * kr) * NQK + 32 * s2 + 8 * rg); }
                  const int kc = k0f + 8 * rg < 0 ? 0 : k0f + 8 * rg;
#pragma unroll
                  for (int dt = 0; dt < 4; ++dt) f.v[dt] = ld16(Vr + (size_t)(16 * dt + n) * (16 * 512) + kc); }
                f32x4 acc[2]; att_qk(acc, f, qf[ct], i0, i0);
#pragma unroll
                for (int i = 0; i < 8; ++i) { const int kf = k0f + 8 * rg + i, di = (Qf + n) - kf;
                    const float add = (kf >= 0 && di >= 33 && di <= 128) ? tab[t5b(16 * di)] : -INFINITY; if (i < 4) acc[0][i] += add; else acc[1][i - 4] += add; }
                const bf16x8 p = att_softmax_refm(acc[0], acc[1]); att_pv_l(st[ct], f, p); } }
    }
    if (MIX == 3) {
        const int cnt = own < 3 ? own : 3;
#pragma unroll
        for (int ct = 0; ct < 2; ++ct) { const size_t pr = ((size_t)(b * 8 + h) * T + q0 + 16 * ct + n) * 3; float ladd = 0.f;
            float pl[3]; v2u pv[3][4];
#pragma unroll
            for (int sl = 0; sl < 3; ++sl) { const size_t ps = pr + (sl < cnt ? sl : 0); pl[sl] = PARTL[ps];
#pragma unroll
                for (int dt = 0; dt < 4; ++dt) pv[sl][dt] = *(const v2u*)(PARTO + ps * 64 + 16 * dt + 4 * rg); }
#pragma unroll
            for (int sl = 0; sl < 3; ++sl) if (sl < cnt) { ladd += pl[sl];
#pragma unroll
                for (int dt = 0; dt < 4; ++dt) st[ct].ot[dt] = st[ct].ot[dt] + (f32x4){bf_lo(pv[sl][dt].x), bf_hi(pv[sl][dt].x), bf_lo(pv[sl][dt].y), bf_hi(pv[sl][dt].y)}; }
            st[ct].lv[0] += ladd; }
    }
#pragma unroll
    for (int ct = 0; ct < 2; ++ct) { att_finish_l(st[ct], 1.f);
        bf16* orow = OB + (size_t)(b * T + (MIX == 1 ? 256 * u256 + 2 * wave + ct + 16 * n : q0 + 16 * ct + n)) * DM + OC + h * 64 + 4 * rg;
#pragma unroll
        for (int dt = 0; dt < 4; ++dt) { v2u w; w.x = cvt_pk(st[ct].ot[dt][0], st[ct].ot[dt][1]); w.y = cvt_pk(st[ct].ot[dt][2], st[ct].ot[dt][3]); *(v2u*)(orow + 16 * dt) = w; } }
}

constexpr int NSA_WLDS = 8 * 128 + 8 * 16 + 32 * 68;
__device__ __forceinline__ void att_nsa_unit(int b, int g, int t0, int lane, const bf16* QK, const bf16* VT, const bf16* KC, const bf16* VCT, bf16* OB, const LAS float* tabs, LAS float* wl, const unsigned* KMX) {
    asm volatile("" : "+v"(lane));
    const int n = lane & 15, rg = lane >> 4, bg = b * 2 + g, hd = 4 * g + (n & 3);
    LAS float* imp = wl; LAS int* sel = (LAS int*)(wl + 1024); LAS float* outl = wl + 1024 + 128;
    const LAS float* tab = tabs + hd * 32;
    int qpos[2]; float gate[3][2];
    auto load_q = [&](bf16x8 (&q)[2], int ct) {
#pragma unroll
        for (int s = 0; s < 2; ++s) q[s] = ld16(QK + (size_t)(b * T + t0 + 4 * ct + (n >> 2)) * NQK + C_QA + hd * 64 + 32 * s + 8 * rg); };
    float qn[2];
#pragma unroll
    for (int ct = 0; ct < 2; ++ct) { const int tk = t0 + 4 * ct + (n >> 2); qpos[ct] = tk; { bf16x8 qt[2]; load_q(qt, ct); qn[ct] = q_norm(qt); }
#pragma unroll
        for (int br = 0; br < 3; ++br) gate[br][ct] = sigmoidf(bf2f(VT[(size_t)(R_GA + br * 8 + hd) * M + (size_t)b * T + tk])); }
    const float tmx = tabs[768 + hd];
#pragma unroll
    for (int i = 0; i < 16; ++i) imp[lane + 64 * i] = 0.f;
    AttSt st[2]; att_init(st[0]); att_init(st[1]);
    const f32x4 z4 = {0.f, 0.f, 0.f, 0.f};
    const bf16* Kc = KC + (size_t)bg * 512 * 64; const bf16* Vc = VCT + (size_t)bg * 64 * 512;
    const int cmax = (t0 + 7 - 31) >> 4;
    auto cmp_fix = [&](f32x4 (&acc)[2], int k0, int qp) {
#pragma unroll
        for (int i = 0; i < 8; ++i) { const int dc = qp - 16 * (k0 + i) - 31; const float add = dc >= 0 ? tab[t5b(dc)] : -INFINITY; if (i < 4) acc[0][i] += add; else acc[1][i - 4] += add; } };
    if (cmax >= 0) {
        bf16x8 qf[2][2]; load_q(qf[0], 0); load_q(qf[1], 1);
        const int nh = (cmax >> 5) + 1;
        { auto cstep = [&](const KVFrag& f, int hc) {
#pragma unroll
                for (int ct = 0; ct < 2; ++ct) { f32x4 acc[2]; att_qk(acc, f, qf[ct], z4, z4); cmp_fix(acc, 32 * hc + 8 * rg, qpos[ct]); const bf16x8 p = att_softmax(st[ct], acc[0], acc[1]); att_pv(st[ct], f, p); } };
          KVFrag fa, fb; kv_load(fa, Kc, 64, Vc, 512, 0, n, rg);
          for (int hc = 0; hc < nh; hc += 2) { kv_load(fb, Kc, 64, Vc, 512, 32 * (hc + 1 < nh ? hc + 1 : hc), n, rg); cstep(fa, hc); if (hc + 1 >= nh) break;
              kv_load(fa, Kc, 64, Vc, 512, 32 * (hc + 2 < nh ? hc + 2 : hc + 1), n, rg); cstep(fb, hc + 1); } }
        float mfin[2], linv[2];
#pragma unroll
        for (int ct = 0; ct < 2; ++ct) { const float lt = rg_sum(st[ct].l); linv[ct] = lt > 0.f ? 1.f / lt : 0.f; mfin[ct] = st[ct].m == -INFINITY ? 0.f : st[ct].m; }
        LDS_WAIT();
        { auto istep = [&](const KVFrag& f, int hc) {
#pragma unroll
            for (int ct = 0; ct < 2; ++ct) { f32x4 acc[2]; att_qk(acc, f, qf[ct], z4, z4); cmp_fix(acc, 32 * hc + 8 * rg, qpos[ct]);
#pragma unroll
                for (int e = 0; e < 2; ++e) { float pe[4];
#pragma unroll
                    for (int i = 0; i < 4; ++i) pe[i] = exp2f(acc[e][i] - mfin[ct]) * linv[ct];
                    float G = (pe[0] + pe[1]) + (pe[2] + pe[3]), Lst = pe[3];
                    G += __shfl_xor(G, 1); G += __shfl_xor(G, 2); Lst += __shfl_xor(Lst, 1); Lst += __shfl_xor(Lst, 2);
                    if ((n & 3) == 0) { const int nb = 8 * hc + 2 * rg + e; LAS float* ip = imp + (4 * ct + (n >> 2)) * 128 + nb;
                        __hip_atomic_fetch_add(ip, G, __ATOMIC_RELAXED, __HIP_MEMORY_SCOPE_WORKGROUP); if (nb + 1 < 128) __hip_atomic_fetch_add(ip + 1, Lst, __ATOMIC_RELAXED, __HIP_MEMORY_SCOPE_WORKGROUP); } } }
            };
          KVFrag fa, fb; kv_load(fa, Kc, 64, Vc, 512, 0, n, rg);
          for (int hc = 0; hc < nh; hc += 2) { kv_load(fb, Kc, 64, Vc, 512, 32 * (hc + 1 < nh ? hc + 1 : hc), n, rg); istep(fa, hc); if (hc + 1 >= nh) break;
              kv_load(fa, Kc, 64, Vc, 512, 32 * (hc + 2 < nh ? hc + 2 : hc + 1), n, rg); istep(fb, hc + 1); } }
    }
#pragma unroll
    for (int ct = 0; ct < 2; ++ct) { att_finish(st[ct], gate[0][ct]);
#pragma unroll
        for (int dt = 0; dt < 4; ++dt) *(LAS f32x4*)(outl + (16 * ct + n) * 68 + 16 * dt + 4 * rg) = st[ct].ot[dt]; }
    LDS_WAIT();
    {
        const int tki = lane >> 3, sub = lane & 7, tk = t0 + tki, cur = tk >> 6;
        unsigned key[16];
#pragma unroll
        for (int k4 = 0; k4 < 4; ++k4) { const f32x4 v = *(const LAS f32x4*)(imp + tki * 128 + sub * 16 + 4 * k4);
#pragma unroll
            for (int i = 0; i < 4; ++i) { const int nb = sub * 16 + 4 * k4 + i; const bool forced = nb == 0 || nb == cur || nb == cur - 1;
                key[4 * k4 + i] = nb > cur ? 0u : (forced ? (0x7f000000u | (unsigned)(127 - nb)) : ((__float_as_uint(v[i]) & ~127u) | (unsigned)(127 - nb))); } }
        for (int r = 0; r < 16; ++r) { unsigned mx = key[0];
#pragma unroll
            for (int i = 1; i < 16; ++i) mx = key[i] > mx ? key[i] : mx;
            unsigned w;
            w = __shfl_xor(mx, 1); mx = w > mx ? w : mx; w = __shfl_xor(mx, 2); mx = w > mx ? w : mx; w = __shfl_xor(mx, 4); mx = w > mx ? w : mx;
            if (sub == 0) sel[tki * 16 + r] = mx ? (int)(127u - (mx & 127u)) : -1;
#pragma unroll
            for (int i = 0; i < 16; ++i) key[i] = key[i] == mx ? 0u : key[i]; }
    }
    LDS_WAIT();
    const bf16* Ks = QK + (size_t)b * T * NQK + C_KSA + g * 64; const bf16* Vs = VT + (size_t)(R_VSA + g * 64) * M + (size_t)b * T;
#pragma unroll 1
    for (int ct = 0; ct < 2; ++ct) {
        AttSt ss; att_init(ss);
        const int mytok = n >> 2;
        bf16x8 qc[2]; load_q(qc, ct); const int qpc = ct ? qpos[1] : qpos[0]; const float qnc = ct ? qn[1] : qn[0], g1c = ct ? gate[1][1] : gate[1][0];
        const float nrs = -(qnc * sqrtf(__uint_as_float(KMX[b * 28 + 24 + g])) * 1.0001f + tmx); const f32x4 zs = {nrs, nrs, nrs, nrs};
        bf16x8 kf[4][2][2], vf[4][4]; int blk[4], myblk;
        auto rd_sel = [&](int r) {
#pragma unroll
            for (int tq = 0; tq < 4; ++tq) blk[tq] = __builtin_amdgcn_readfirstlane(sel[(4 * ct + tq) * 16 + r]); };
        auto ldk = [&](int hh) {
#pragma unroll
            for (int tq = 0; tq < 4; ++tq) { const bf16* kr = Ks + (size_t)(64 * (blk[tq] < 0 ? 0 : blk[tq]) + 32 * hh + 8 * (n >> 2) + (n & 3)) * NQK + 8 * rg;
#pragma unroll
                for (int e = 0; e < 2; ++e)
#pragma unroll
                    for (int s2 = 0; s2 < 2; ++s2) kf[tq][e][s2] = ld16(kr + (size_t)(4 * e) * NQK + 32 * s2); } };
        auto ldv = [&](int hh) {
#pragma unroll
            for (int tq = 0; tq < 4; ++tq) { const bf16* vr = Vs + (size_t)n * M + 64 * (blk[tq] < 0 ? 0 : blk[tq]) + 32 * hh + 8 * rg;
#pragma unroll
                for (int dt = 0; dt < 4; ++dt) vf[tq][dt] = ld16(vr + (size_t)(16 * dt) * M); } };
        rd_sel(0); ldk(0); ldv(0);
#pragma unroll 1
        for (int i = 0; i < 32; ++i) {
            const int hh = i & 1;
            myblk = mytok == 0 ? blk[0] : (mytok == 1 ? blk[1] : (mytok == 2 ? blk[2] : blk[3]));
            f32x4 acc[2] = {zs, zs};
#pragma unroll
            for (int tq = 0; tq < 4; ++tq) { const unsigned msk = (mytok == tq) ? 0xffffffffu : 0u;
                bf16x8 qm[2];
#pragma unroll
                for (int s2 = 0; s2 < 2; ++s2) { u32x4t w = __builtin_bit_cast(u32x4t, qc[s2]); w.x &= msk; w.y &= msk; w.z &= msk; w.w &= msk; qm[s2] = __builtin_bit_cast(bf16x8, w); }
                acc[0] = MFMA16(kf[tq][0][0], qm[0], acc[0]); acc[1] = MFMA16(kf[tq][1][0], qm[0], acc[1]);
                acc[0] = MFMA16(kf[tq][0][1], qm[1], acc[0]); acc[1] = MFMA16(kf[tq][1][1], qm[1], acc[1]); }
            const int kp0 = 64 * myblk + 32 * hh + 8 * rg; const bool live = myblk >= 0;
            int nblk[4];
            { const int rn = (i + 1 < 32 ? i + 1 : i) >> 1;
#pragma unroll
              for (int tq = 0; tq < 4; ++tq) nblk[tq] = __builtin_amdgcn_readfirstlane(sel[(4 * ct + tq) * 16 + rn]); }
            int cblk[4];
#pragma unroll
            for (int tq = 0; tq < 4; ++tq) { cblk[tq] = blk[tq]; blk[tq] = nblk[tq]; }
            ldk((i + 1 < 32 ? i + 1 : i) & 1);
#pragma unroll
            for (int j = 0; j < 8; ++j) { const int d = qpc - (kp0 + j); const float add = (live && d >= 0) ? tab[t5b(d)] : -INFINITY; if (j < 4) acc[0][j] += add; else acc[1][j - 4] += add; }
            const bf16x8 p = att_softmax_ref(ss, acc[0], acc[1]);
#pragma unroll
            for (int tq = 0; tq < 4; ++tq) { const unsigned msk = (mytok == tq) ? 0xffffffffu : 0u; u32x4t w = __builtin_bit_cast(u32x4t, p); w.x &= msk; w.y &= msk; w.z &= msk; w.w &= msk;
                const bf16x8 pm = __builtin_bit_cast(bf16x8, w);
#pragma unroll
                for (int dt = 0; dt < 4; ++dt) ss.ot[dt] = MFMA16(vf[tq][dt], pm, ss.ot[dt]); }
            (void)cblk;
            ldv((i + 1 < 32 ? i + 1 : i) & 1);
        }
        att_finish(ss, g1c);
#pragma unroll
        for (int dt = 0; dt < 4; ++dt) { LAS f32x4* op = (LAS f32x4*)(outl + (16 * ct + n) * 68 + 16 * dt + 4 * rg); *op = *op + ss.ot[dt]; }
    }
    {
        const bf16* Kw = QK + (size_t)b * T * NQK + C_KWA + g * 64; const bf16* Vw = VT + (size_t)(R_VWA + g * 64) * M + (size_t)b * T;
        bf16x8 qf[2][2]; load_q(qf[0], 0); load_q(qf[1], 1);
        att_init(st[0]); att_init(st[1]);
        const float kmw = sqrtf(__uint_as_float(KMX[b * 28 + 26 + g])) * 1.0001f;
        const int h0 = (t0 - 511) < 0 ? 0 : ((t0 - 511) >> 5), h1 = (t0 + 7) >> 5;
        { auto wstep = [&](const KVFrag& f, int hc) {
#pragma unroll
            for (int ct = 0; ct < 2; ++ct) { const float nrw = -(qn[ct] * kmw + tmx); const f32x4 zw = {nrw, nrw, nrw, nrw}; f32x4 acc[2]; att_qk(acc, f, qf[ct], zw, zw);
                const int kp0 = 32 * hc + 8 * rg;
#pragma unroll
                for (int i = 0; i < 8; ++i) { const int d = qpos[ct] - (kp0 + i); const float add = (d >= 0 && d <= 511) ? tab[t5b(d)] : -INFINITY; if (i < 4) acc[0][i] += add; else acc[1][i - 4] += add; }
                const bf16x8 p = att_softmax_ref(st[ct], acc[0], acc[1]); att_pv(st[ct], f, p); }
            };
          KVFrag fa, fb; kv_load(fa, Kw, NQK, Vw, M, 32 * h0, n, rg);
          for (int hc = h0; hc <= h1; hc += 2) { kv_load(fb, Kw, NQK, Vw, M, 32 * (hc + 1 <= h1 ? hc + 1 : hc), n, rg); wstep(fa, hc); if (hc + 1 > h1) break;
              kv_load(fa, Kw, NQK, Vw, M, 32 * (hc + 2 <= h1 ? hc + 2 : hc + 1), n, rg); wstep(fb, hc + 1); } }
#pragma unroll
        for (int ct = 0; ct < 2; ++ct) { att_finish(st[ct], gate[2][ct]);
            bf16* orow = OB + (size_t)(b * T + qpos[ct]) * DM + hd * 64 + 4 * rg;
#pragma unroll
            for (int dt = 0; dt < 4; ++dt) { const f32x4 o = *(const LAS f32x4*)(outl + (16 * ct + n) * 68 + 16 * dt + 4 * rg) + st[ct].ot[dt];
                v2u w; w.x = cvt_pk(o[0], o[1]); w.y = cvt_pk(o[2], o[3]); *(v2u*)(orow + 16 * dt) = w; } }
    }
    LDS_WAIT();
}


__device__ __forceinline__ float gelu_fast(float x) { const float u = 0.7978845608028654f * (x + 0.044715f * x * x * x); return x / (1.f + exp2f(-2.f * LOG2E * u)); }
__device__ __forceinline__ void compress_unit(LAS unsigned char* L, int which, int bg, int cb, const bf16* QK, const bf16* W1t, const bf16* W2t, const float* hb, bf16* KC, bf16* VCT, int wave, int lane) {
    const int n = lane & 15, rg = lane >> 4, b = bg >> 1, g = bg & 1, col = (which ? C_VCA : C_KCA) + g * 64, n0 = 32 * wave;
    f32x4 acc[2][2];
#pragma unroll
    for (int i = 0; i < 2; ++i)
#pragma unroll
        for (int j = 0; j < 2; ++j) acc[i][j] = (f32x4){0.f, 0.f, 0.f, 0.f};
    const bf16* ap[2]; const bf16* bp[2];
#pragma unroll
    for (int i = 0; i < 2; ++i) { ap[i] = W1t + (size_t)(n0 + 16 * i + n) * 2048 + 8 * rg;
        int c = 32 * cb + 16 * i + n; c = c > 510 ? 510 : c; bp[i] = QK + (size_t)(b * T + 16 * c) * NQK + col + 8 * rg; }
#pragma unroll 4
    for (int s = 0; s < 64; ++s) { bf16x8 af[2], bf[2];
#pragma unroll
        for (int i = 0; i < 2; ++i) { af[i] = ld16(ap[i] + 32 * s); bf[i] = ld16(bp[i] + (size_t)(s >> 1) * NQK + 32 * (s & 1)); }
#pragma unroll
        for (int i = 0; i < 2; ++i)
#pragma unroll
            for (int j = 0; j < 2; ++j) acc[i][j] = MFMA16(af[i], bf[j], acc[i][j]); }
    LAS unsigned char* hid = L;
#pragma unroll
    for (int i = 0; i < 2; ++i) { const f32x4 hbv = *(const f32x4*)(hb + n0 + 16 * i + 4 * rg);
#pragma unroll
        for (int j = 0; j < 2; ++j) { const f32x4 v = acc[i][j] + hbv; v2u w; w.x = cvt_pk(gelu_fast(v[0]), gelu_fast(v[1])); w.y = cvt_pk(gelu_fast(v[2]), gelu_fast(v[3]));
            *(LAS v2u*)(hid + (16 * j + n) * 528 + (n0 + 16 * i + 4 * rg) * 2) = w; } }
    __syncthreads();
    const int ct2 = wave >> 2, dt = wave & 3;
    f32x4 o = {0.f, 0.f, 0.f, 0.f};
#pragma unroll
    for (int s = 0; s < 8; ++s) { const bf16x8 hf = *(const LAS bf16x8*)(hid + (16 * ct2 + n) * 528 + (32 * s + 8 * rg) * 2); const bf16x8 wf = ld16(W2t + (size_t)(16 * dt + n) * 256 + 32 * s + 8 * rg);
        o = which ? MFMA16(hf, wf, o) : MFMA16(wf, hf, o); }
    if (!which) { const int c = 32 * cb + 16 * ct2 + n; v2u w; w.x = cvt_pk(o[0], o[1]); w.y = cvt_pk(o[2], o[3]); if (c == 511) { w.x = 0u; w.y = 0u; }
        *(v2u*)(KC + ((size_t)bg * 512 + c) * 64 + 16 * dt + 4 * rg) = w; }
    else { const int c = 32 * cb + 16 * ct2 + 4 * rg; v2u w; w.x = cvt_pk(o[0], o[1]); w.y = cvt_pk(o[2], c + 3 == 511 ? 0.f : o[3]);
        *(v2u*)(VCT + ((size_t)bg * 64 + 16 * dt + n) * 512 + c) = w; }
    __syncthreads();
}
__device__ __forceinline__ float log_sigmoid_f(float x) { return x >= 0.f ? -log1pf(__expf(-x)) : x - log1pf(__expf(x)); }
__device__ __forceinline__ void cumsum_unit(LAS unsigned char* L, const bf16* fcrow, float fb, float* cum, int tid) {
    const int lane = tid & 63, wave = tid >> 6;
    float v[16]; const v4u* p = (const v4u*)(fcrow + tid * 16); const v4u w0 = p[0], w1 = p[1];
    const unsigned ww[8] = {w0.x, w0.y, w0.z, w0.w, w1.x, w1.y, w1.z, w1.w};
    float run = 0.f;
#pragma unroll
    for (int i = 0; i < 8; ++i) { run += log_sigmoid_f(bf_lo(ww[i]) + fb); v[2 * i] = run; run += log_sigmoid_f(bf_hi(ww[i]) + fb); v[2 * i + 1] = run; }
    float incl = run;
#pragma unroll
    for (int o = 1; o < 64; o <<= 1) { const float u = __shfl_up(incl, o); if (lane >= o) incl += u; }
    LAS float* wt = (LAS float*)L;
    if (lane == 63) wt[wave] = incl;
    __syncthreads();
    float base = incl - run;
    for (int w = 0; w < wave; ++w) base += wt[w];
    f32x4* o4 = (f32x4*)(cum + tid * 16);
#pragma unroll
    for (int i = 0; i < 4; ++i) o4[i] = (f32x4){(base + v[4 * i]) * LOG2E, (base + v[4 * i + 1]) * LOG2E, (base + v[4 * i + 2]) * LOG2E, (base + v[4 * i + 3]) * LOG2E};
    __syncthreads();
}


constexpr int NSA_MASK_OFF = 4096, NSA_LUT_OFF = 8192, NSA_LUT_PAD = 64, NSA_LUT_N = 3072, NSA_ST_OFF = 8192 + 4 * NSA_LUT_N * 4, NSA_IMP_OFF = NSA_ST_OFF + 32768, NSA_WIN_BUF = 32768;
static_assert(NSA_ST_OFF + 2 * NSA_WIN_BUF <= RING_BYTES && NSA_IMP_OFF + 8 * 4096 <= NSA_ST_OFF + 2 * NSA_WIN_BUF, "NSA LDS map");
__device__ __forceinline__ int swz7(int r) { return ((r >> 4) & 1) * 5 + ((r >> 1) & 1) * 2; }
__device__ __forceinline__ int swzv(int d) { return ((d >> 3) & 1) * 5 + ((d >> 1) & 1) * 2; }
__device__ __forceinline__ void nsa_build_lut(LAS unsigned char* L, const LAS float* tabs, int g, int tid) {
    LAS float* lut = (LAS float*)(L + NSA_LUT_OFF);
    for (int i = tid; i < 4 * NSA_LUT_N; i += NTHR) { const int hl = i / NSA_LUT_N, d = i % NSA_LUT_N - NSA_LUT_PAD; lut[i] = d >= 0 ? tabs[(4 * g + hl) * 32 + t5b(d)] : -INFINITY; }
}
__device__ __forceinline__ void att_nsa_coop_unit(LAS unsigned char* L, int b, int g, int t0, int tid, const bf16* QK, const bf16* VT, const bf16* KC, const bf16* VCT, bf16* OB, const LAS float* tabs, const unsigned* KMX) {
    asm volatile("" : "+v"(tid));
    const int lane = tid & 63, wave = __builtin_amdgcn_readfirstlane(tid >> 6), n = lane & 15, rg = lane >> 4, bg = b * 2 + g, hd = 4 * g + (n & 3), tw0 = t0 + 8 * wave;
    const LAS float* tab = tabs + hd * 32;
    const LAS float* lut = (const LAS float*)(L + NSA_LUT_OFF) + (n & 3) * NSA_LUT_N + NSA_LUT_PAD;
    LAS unsigned char* stb = L + NSA_ST_OFF;
    LAS float* imp = (LAS float*)(L + NSA_IMP_OFF) + wave * 1024;
    LAS unsigned* msk = (LAS unsigned*)(L + NSA_MASK_OFF) + wave * 32;
    bf16x8 qf[2][2]; int qpos[2]; float gate[3][2], qn[2];
#pragma unroll
    for (int ct = 0; ct < 2; ++ct) { const int tk = tw0 + 4 * ct + (n >> 2); qpos[ct] = tk;
#pragma unroll
        for (int s = 0; s < 2; ++s) qf[ct][s] = ld16(QK + (size_t)(b * T + tk) * NQK + C_QA + hd * 64 + 32 * s + 8 * rg);
        qn[ct] = q_norm(qf[ct]);
#pragma unroll
        for (int br = 0; br < 3; ++br) gate[br][ct] = sigmoidf(bf2f(VT[(size_t)(R_GA + br * 8 + hd) * M + (size_t)b * T + tk])); }
    const float tmx = tabs[768 + hd];
#pragma unroll
    for (int i = 0; i < 16; ++i) imp[lane + 64 * i] = 0.f;
    f32x4 outv[2][4];
    const f32x4 z4 = {0.f, 0.f, 0.f, 0.f};
    const int lrow = tid >> 3, lch = tid & 7;
    const int lofk = 128 * lrow + 16 * (lch ^ swz7(lrow)), lofv = 8192 + 128 * lrow + 16 * (lch ^ swzv(lrow));
    int kro[2][2], vro[2][4];
#pragma unroll
    for (int e = 0; e < 2; ++e) { const int rho = 8 * (n >> 2) + 4 * e + (n & 3);
#pragma unroll
        for (int s = 0; s < 2; ++s) kro[e][s] = 128 * rho + 16 * ((4 * s + rg) ^ swz7(rho)); }
#pragma unroll
    for (int hh = 0; hh < 2; ++hh)
#pragma unroll
        for (int dt = 0; dt < 4; ++dt) { const int d = 16 * dt + n; vro[hh][dt] = 8192 + 128 * d + 16 * ((4 * hh + rg) ^ swzv(d)); }
    auto ldfrag = [&](KVFrag& f, const LAS unsigned char* buf, int hh) {
#pragma unroll
        for (int e = 0; e < 2; ++e)
#pragma unroll
            for (int s = 0; s < 2; ++s) f.k[e][s] = *(const LAS bf16x8*)(buf + 4096 * hh + kro[e][s]);
#pragma unroll
        for (int dt = 0; dt < 4; ++dt) f.v[dt] = *(const LAS bf16x8*)(buf + vro[hh][dt]); };
#define NSA_STREAM(KB_, KPB_, VB_, VPB_, HFIRST_, HLAST_, NEED_, BODY_) do { \
        const char* gk_ = (const char*)(KB_) + (size_t)lrow * (KPB_) + 16 * lch; const char* gv_ = (const char*)(VB_) + (size_t)lrow * (VPB_) + 16 * lch; \
        const size_t gks_ = (size_t)64 * (KPB_); const int hf_ = (HFIRST_), hl_ = (HLAST_); \
        int kt_ = hf_ >> 1; const int ktl_ = hl_ >> 1; \
        { const v4u rk_ = *(const v4u*)(gk_ + (size_t)kt_ * gks_), rv_ = *(const v4u*)(gv_ + (size_t)kt_ * 128); *(LAS v4u*)(stb + lofk) = rk_; *(LAS v4u*)(stb + lofv) = rv_; } \
        __syncthreads(); \
        for (int par_ = 0;; par_ ^= 1) { const int nx_ = kt_ < ktl_ ? kt_ + 1 : kt_; \
            const v4u rk_ = *(const v4u*)(gk_ + (size_t)nx_ * gks_), rv_ = *(const v4u*)(gv_ + (size_t)nx_ * 128); \
            _Pragma("unroll") for (int hh_ = 0; hh_ < 2; ++hh_) { const int hc_ = 2 * kt_ + hh_; if (hc_ >= hf_ && hc_ <= hl_ && NEED_(hc_)) { BODY_(stb + par_ * 16384, hh_, hc_); } } \
            *(LAS v4u*)(stb + (par_ ^ 1) * 16384 + lofk) = rk_; *(LAS v4u*)(stb + (par_ ^ 1) * 16384 + lofv) = rv_; \
            __syncthreads(); \
            if (kt_ >= ktl_) break; kt_ = nx_; } } while (0)
    AttSt st[2]; att_init(st[0]); att_init(st[1]);
    const bf16* Kc = KC + (size_t)bg * 512 * 64; const bf16* Vc = VCT + (size_t)bg * 64 * 512;
    const int cmaxu = (t0 + 63 - 31) >> 4, cmaxw = (tw0 + 7 - 31) >> 4;
    auto cmp_fix = [&](f32x4 (&acc)[2], int k0, int qp) {
        const int d0 = qp - 31 - 16 * k0;
#pragma unroll
        for (int i = 0; i < 8; ++i) { int dc = d0 - 16 * i; dc = dc < -1 ? -1 : (dc > 3000 ? 3000 : dc); const float add = lut[dc]; if (i < 4) acc[0][i] += add; else acc[1][i - 4] += add; } };
    float mfin[2] = {0.f, 0.f}, linv[2] = {0.f, 0.f};
    {
        const int nhu = (cmaxu >> 5) + 1;
        auto need_c = [&](int hc) -> bool { return cmaxw >= 0 && hc <= (cmaxw >> 5); };
        auto body1 = [&](const LAS unsigned char* buf, int hh, int hc) { KVFrag f; ldfrag(f, buf, hh);
#pragma unroll
            for (int ct = 0; ct < 2; ++ct) { f32x4 acc[2]; att_qk(acc, f, qf[ct], z4, z4); cmp_fix(acc, 32 * hc + 8 * rg, qpos[ct]); const bf16x8 p = att_softmax(st[ct], acc[0], acc[1]); att_pv(st[ct], f, p); } };
        NSA_STREAM(Kc, 128, Vc, 1024, 0, nhu - 1, need_c, body1);
#pragma unroll
        for (int ct = 0; ct < 2; ++ct) { const float lt = rg_sum(st[ct].l); linv[ct] = lt > 0.f ? 1.f / lt : 0.f; mfin[ct] = st[ct].m == -INFINITY ? 0.f : st[ct].m; }
        float carry[2] = {0.f, 0.f};
        auto body2 = [&](const LAS unsigned char* buf, int hh, int hc) { KVFrag f; ldfrag(f, buf, hh);
#pragma unroll
            for (int ct = 0; ct < 2; ++ct) { f32x4 acc[2]; att_qk(acc, f, qf[ct], z4, z4); cmp_fix(acc, 32 * hc + 8 * rg, qpos[ct]);
                float pe[8];
#pragma unroll
                for (int i = 0; i < 4; ++i) { pe[i] = __builtin_amdgcn_exp2f(acc[0][i] - mfin[ct]) * linv[ct]; pe[4 + i] = __builtin_amdgcn_exp2f(acc[1][i] - mfin[ct]) * linv[ct]; }
                float G0 = (pe[0] + pe[1]) + (pe[2] + pe[3]), L0 = pe[3], G1 = (pe[4] + pe[5]) + (pe[6] + pe[7]), L1 = pe[7];
                G0 += __shfl_xor(G0, 1); G0 += __shfl_xor(G0, 2); L0 += __shfl_xor(L0, 1); L0 += __shfl_xor(L0, 2);
                G1 += __shfl_xor(G1, 1); G1 += __shfl_xor(G1, 2); L1 += __shfl_xor(L1, 1); L1 += __shfl_xor(L1, 2);
                float Lp = __shfl_up(L1, 16); if (rg == 0) Lp = carry[ct];
                carry[ct] = __shfl(L1, (lane + 48) & 63);
                if ((n & 3) == 0) { LAS float* ip = imp + (4 * ct + (n >> 2)) * 128 + 8 * hc + 2 * rg; ip[0] = G0 + Lp; ip[1] = G1 + L0; } } };
        NSA_STREAM(Kc, 128, Vc, 1024, 0, nhu - 1, need_c, body2);
        if (cmaxw >= 0 && rg == 0 && (n & 3) == 0) { const int nbx = 8 * ((cmaxw >> 5) + 1);
            if (nbx < 128) {
#pragma unroll
                for (int ct = 0; ct < 2; ++ct) imp[(4 * ct + (n >> 2)) * 128 + nbx] = carry[ct]; } }
    }
#pragma unroll
    for (int ct = 0; ct < 2; ++ct) { att_finish(st[ct], gate[0][ct]);
#pragma unroll
        for (int dt = 0; dt < 4; ++dt) outv[ct][dt] = st[ct].ot[dt]; }
    LDS_WAIT();
    {
        const int tki = lane >> 3, sub = lane & 7, tk = tw0 + tki, cur = tk >> 6;
        unsigned key[16];
#pragma unroll
        for (int k4 = 0; k4 < 4; ++k4) { const f32x4 v = *(const LAS f32x4*)(imp + tki * 128 + sub * 16 + 4 * k4);
#pragma unroll
            for (int i = 0; i < 4; ++i) { const int nb = sub * 16 + 4 * k4 + i; const bool forced = nb == 0 || nb == cur || nb == cur - 1;
                key[4 * k4 + i] = nb > cur ? 0u : (forced ? (0x7f000000u | (unsigned)(127 - nb)) : ((__float_as_uint(v[i]) & ~127u) | (unsigned)(127 - nb))); } }
        unsigned mword = 0u;
        for (int r = 0; r < 16; ++r) { unsigned mx = key[0];
#pragma unroll
            for (int i = 1; i < 16; ++i) mx = key[i] > mx ? key[i] : mx;
            unsigned w;
            w = __shfl_xor(mx, 1); mx = w > mx ? w : mx; w = __shfl_xor(mx, 2); mx = w > mx ? w : mx; w = __shfl_xor(mx, 4); mx = w > mx ? w : mx;
            if (mx) { const int nsel = (int)(127u - (mx & 127u)); if ((nsel >> 5) == sub) mword |= 1u << (nsel & 31); }
#pragma unroll
            for (int i = 0; i < 16; ++i) key[i] = key[i] == mx ? 0u : key[i]; }
        if (sub < 4) msk[tki * 4 + sub] = mword;
    }
    {
        const bf16* Kw = QK + (size_t)b * T * NQK + C_KWA + g * 64; const bf16* Vw = VT + (size_t)(R_VWA + g * 64) * M + (size_t)b * T;
        att_init(st[0]); att_init(st[1]);
        const float kmw = sqrtf(__uint_as_float(KMX[b * 28 + 26 + g])) * 1.0001f;
        const int h0u = (t0 - 511) < 0 ? 0 : ((t0 - 511) >> 5), h1u = (t0 + 63) >> 5, h0w = (tw0 - 511) < 0 ? 0 : ((tw0 - 511) >> 5), h1w = (tw0 + 7) >> 5;
        auto need_w = [&](int hc) -> bool { return hc >= h0w && hc <= h1w; };
        auto bodyw = [&](const LAS unsigned char* buf, int hh, int hc) { KVFrag f; ldfrag(f, buf, hh);
#pragma unroll
            for (int ct = 0; ct < 2; ++ct) { const float nrw = -(qn[ct] * kmw + tmx); const f32x4 zw = {nrw, nrw, nrw, nrw}; f32x4 acc[2]; att_qk(acc, f, qf[ct], zw, zw);
                const int dl = qpos[ct] - (32 * hc + 8 * rg); const LAS float* lp = lut + dl - 7;
#pragma unroll
                for (int i = 0; i < 8; ++i) { float add = lp[7 - i]; if (hc <= h0w + 1 && dl - i > 511) add = -INFINITY; if (i < 4) acc[0][i] += add; else acc[1][i - 4] += add; }
                const bf16x8 p = att_softmax_refm(acc[0], acc[1]); att_pv_l(st[ct], f, p); } };
        NSA_STREAM(Kw, (size_t)NQK * 2, Vw, (size_t)M * 2, h0u, h1u, need_w, bodyw);
#pragma unroll
        for (int ct = 0; ct < 2; ++ct) { att_finish_l(st[ct], gate[2][ct]);
            bf16* orow = OB + (size_t)(b * T + qpos[ct]) * DM + hd * 64 + 4 * rg;
#pragma unroll
            for (int dt = 0; dt < 4; ++dt) { const f32x4 o = outv[ct][dt] + st[ct].ot[dt]; v2u wv; wv.x = cvt_pk(o[0], o[1]); wv.y = cvt_pk(o[2], o[3]); *(v2u*)(orow + 16 * dt) = wv; } }
    }
    __syncthreads();
    {
        const char* Ks = (const char*)(QK + (size_t)b * T * NQK + C_KSA + g * 64); const char* Vs = (const char*)(VT + (size_t)(R_VSA + g * 64) * M + (size_t)b * T);
        const int curu = t0 >> 6, nwin = (curu >> 1) + 1;
        AttSt ss[2]; att_init(ss[0]); att_init(ss[1]);
        float nrs[2];
#pragma unroll
        for (int ct = 0; ct < 2; ++ct) nrs[ct] = -(qn[ct] * sqrtf(__uint_as_float(KMX[b * 28 + 24 + g])) * 1.0001f + tmx);
        int wl_l[4]; size_t wl_g[4]; bool wl_k[4];
#pragma unroll
        for (int j = 0; j < 4; ++j) { const int q = tid + 512 * j; const bool kk = q < 1024; const int q2 = q & 1023, bi = q2 >> 9, row = (q2 >> 3) & 63, c = q2 & 7; wl_k[j] = kk;
            wl_l[j] = bi * 16384 + (kk ? 0 : 8192) + 128 * row + 16 * (c ^ (kk ? swz7(row) : swzv(row)));
            wl_g[j] = kk ? (size_t)(64 * bi + row) * (NQK * 2) + 16 * c : (size_t)row * ((size_t)M * 2) + (size_t)(64 * bi) * 2 + 16 * c; }
        auto wload = [&](v4u (&r)[4], int w) {
#pragma unroll
            for (int j = 0; j < 4; ++j) r[j] = *(const v4u*)((wl_k[j] ? Ks + (size_t)(128 * w) * (NQK * 2) : Vs + (size_t)(128 * w) * 2) + wl_g[j]); };
        auto wstore = [&](const v4u (&r)[4], int par) {
#pragma unroll
            for (int j = 0; j < 4; ++j) *(LAS v4u*)(stb + par * NSA_WIN_BUF + wl_l[j]) = r[j]; };
        const int mytok = n >> 2;
        { v4u r[4]; wload(r, 0); wstore(r, 0); }
        __syncthreads();
        int w = 0;
        for (int par = 0;; par ^= 1) {
            const int nw = w + 1 < nwin ? w + 1 : w;
            v4u r[4]; wload(r, nw);
            const LAS unsigned char* wb = stb + par * NSA_WIN_BUF;
            unsigned anyb[2], mybits[2];
#pragma unroll
            for (int ct = 0; ct < 2; ++ct) { anyb[ct] = 0u; mybits[ct] = 0u;
#pragma unroll
                for (int tq = 0; tq < 4; ++tq) { const unsigned bt = (__builtin_amdgcn_readfirstlane(msk[(4 * ct + tq) * 4 + (w >> 4)]) >> ((2 * w) & 31)) & 3u; anyb[ct] |= bt; mybits[ct] = (mytok == tq) ? bt : mybits[ct]; } }
            for (int bl = 0; bl < 2; ++bl) {
                const bool a0 = (anyb[0] >> bl) & 1u, a1 = (anyb[1] >> bl) & 1u;
                if (!(a0 || a1)) continue;
#pragma unroll
                for (int hh = 0; hh < 2; ++hh) {
                    KVFrag f; const LAS unsigned char* kb = wb + bl * 16384 + 4096 * hh; const LAS unsigned char* vb = wb + bl * 16384 + 8192;
#pragma unroll
                    for (int e = 0; e < 2; ++e)
#pragma unroll
                        for (int s = 0; s < 2; ++s) f.k[e][s] = *(const LAS bf16x8*)(kb + kro[e][s]);
#pragma unroll
                    for (int dt = 0; dt < 4; ++dt) { const int d = 16 * dt + n; f.v[dt] = *(const LAS bf16x8*)(vb + 128 * d + 16 * ((4 * hh + rg) ^ swzv(d))); }
#pragma unroll
                    for (int ct = 0; ct < 2; ++ct) {
                        if (!(ct ? a1 : a0)) continue;
                        const float ini = ((mybits[ct] >> bl) & 1u) ? nrs[ct] : -INFINITY; const f32x4 zi = {ini, ini, ini, ini};
                        f32x4 acc[2]; att_qk(acc, f, qf[ct], zi, zi);
                        int dl = qpos[ct] - (64 * (2 * w + bl) + 32 * hh + 8 * rg); dl = dl > 3000 ? 3000 : dl;
                        const LAS float* lp = lut + dl - 7;
#pragma unroll
                        for (int i = 0; i < 8; ++i) { const float add = lp[7 - i]; if (i < 4) acc[0][i] += add; else acc[1][i - 4] += add; }
                        const bf16x8 p = att_softmax_refm(acc[0], acc[1]); att_pv_l(ss[ct], f, p); }
                }
            }
            wstore(r, par ^ 1);
            __syncthreads();
            if (w + 1 >= nwin) break;
            w = nw;
        }
#pragma unroll
        for (int ct = 0; ct < 2; ++ct) { att_finish_l(ss[ct], sigmoidf(bf2f(VT[(size_t)(R_GA + 8 + hd) * M + (size_t)b * T + qpos[ct]])));
            bf16* orow = OB + (size_t)(b * T + qpos[ct]) * DM + hd * 64 + 4 * rg;
#pragma unroll
            for (int dt = 0; dt < 4; ++dt) { const v2u pv = *(const v2u*)(orow + 16 * dt); const f32x4 o = ss[ct].ot[dt] + (f32x4){bf_lo(pv.x), bf_hi(pv.x), bf_lo(pv.y), bf_hi(pv.y)};
                v2u wv; wv.x = cvt_pk(o[0], o[1]); wv.y = cvt_pk(o[2], o[3]); *(v2u*)(orow + 16 * dt) = wv; } }
    }
#undef NSA_STREAM
}


constexpr int FOX_OFF = 8192;
template <int NB>
__device__ __forceinline__ void att_fox_unit(LAS unsigned char* L, int b, int h, int u256, int tid, const bf16* QK, const bf16* VT, const float* CUM, bf16* OB, const unsigned* KMX) {
    asm volatile("" : "+v"(tid));
    constexpr int BUFSZ = NB * 16384 + 1024, CUM_OFF = NB * 16384;
    const int lane = tid & 63, wave = __builtin_amdgcn_readfirstlane(tid >> 6), n = lane & 15, rg = lane >> 4, qb = 8 * u256 + wave, q0 = qb * 32;
    const char* Kb = (const char*)(QK + (size_t)b * T * NQK + C_KC + h * 64); const char* Vb = (const char*)(VT + (size_t)(R_VC + h * 64) * M + (size_t)b * T);
    const float* cum = CUM + (size_t)(b * 8 + h) * T;
    bf16x8 qf[2][2];
#pragma unroll
    for (int ct = 0; ct < 2; ++ct)
#pragma unroll
        for (int s = 0; s < 2; ++s) qf[ct][s] = ld16(QK + (size_t)(b * T + q0 + 16 * ct + n) * NQK + C_QC + h * 64 + 32 * s + 8 * rg);
    AttSt st[2]; att_init(st[0]); att_init(st[1]);
    const float kmx = sqrtf(__uint_as_float(KMX[b * 28 + 8 + h])) * 1.0001f;
    float base[2];
#pragma unroll
    for (int ct = 0; ct < 2; ++ct) base[ct] = cum[q0 + 16 * ct + n] - q_norm(qf[ct]) * kmx;
    const int lrow = tid >> 3, lch = tid & 7;
    const char* gk = Kb + (size_t)lrow * (NQK * 2) + 16 * lch; const size_t gks = (size_t)64 * NQK * 2;
    const char* gv = Vb + (size_t)lrow * ((size_t)M * 2) + 16 * lch; const size_t gvs = 128;
    const int lk = 128 * lrow + 16 * (lch ^ swz7(lrow)), lv = 8192 + 128 * lrow + 16 * (lch ^ swzv(lrow));
    int kro[2][2], vro[2][4];
#pragma unroll
    for (int e = 0; e < 2; ++e) { const int rho = 8 * (n >> 2) + 4 * e + (n & 3);
#pragma unroll
        for (int s = 0; s < 2; ++s) kro[e][s] = 128 * rho + 16 * ((4 * s + rg) ^ swz7(rho)); }
#pragma unroll
    for (int hh = 0; hh < 2; ++hh)
#pragma unroll
        for (int dt = 0; dt < 4; ++dt) { const int d = 16 * dt + n; vro[hh][dt] = 8192 + 128 * d + 16 * ((4 * hh + rg) ^ swzv(d)); }
    const int nt = (4 * u256 + 4) / NB;
    LAS unsigned char* tb = L + FOX_OFF;
    {   v4u rk[NB], rv[NB]; float rc = 0.f;
#pragma unroll
        for (int bl = 0; bl < NB; ++bl) { rk[bl] = *(const v4u*)(gk + (size_t)bl * gks); rv[bl] = *(const v4u*)(gv + (size_t)bl * gvs); }
        if (tid < 64 * NB) rc = cum[tid];
#pragma unroll
        for (int bl = 0; bl < NB; ++bl) { *(LAS v4u*)(tb + 16384 * bl + lk) = rk[bl]; *(LAS v4u*)(tb + 16384 * bl + lv) = rv[bl]; }
        if (tid < 64 * NB) *(LAS float*)(tb + CUM_OFF + 4 * tid) = rc; }
    __syncthreads();
    for (int kt = 0, par = 0;; ++kt, par ^= 1) {
        const int nx = kt + 1 < nt ? kt + 1 : kt;
        v4u rk[NB], rv[NB]; float rc = 0.f;
#pragma unroll
        for (int bl = 0; bl < NB; ++bl) { rk[bl] = *(const v4u*)(gk + (size_t)(NB * nx + bl) * gks); rv[bl] = *(const v4u*)(gv + (size_t)(NB * nx + bl) * gvs); }
        if (tid < 64 * NB) rc = cum[64 * NB * nx + tid];
        const LAS unsigned char* buf = tb + par * BUFSZ;
#pragma unroll
        for (int hh = 0; hh < 2 * NB; ++hh) { const int hc = 2 * NB * kt + hh;
            if (hc <= qb) { KVFrag f; const LAS unsigned char* bb_ = buf + 16384 * (hh >> 1);
#pragma unroll
                for (int e = 0; e < 2; ++e)
#pragma unroll
                    for (int s = 0; s < 2; ++s) f.k[e][s] = *(const LAS bf16x8*)(bb_ + 4096 * (hh & 1) + kro[e][s]);
#pragma unroll
                for (int dt = 0; dt < 4; ++dt) f.v[dt] = *(const LAS bf16x8*)(bb_ + vro[hh & 1][dt]);
                const f32x4 c0 = *(const LAS f32x4*)(buf + CUM_OFF + 4 * (32 * hh + 8 * rg)), c1 = *(const LAS f32x4*)(buf + CUM_OFF + 4 * (32 * hh + 8 * rg + 4));
                const int k0 = 32 * hc + 8 * rg;
#pragma unroll
                for (int ct = 0; ct < 2; ++ct) { const f32x4 bb = {base[ct], base[ct], base[ct], base[ct]}; f32x4 acc[2]; att_qk(acc, f, qf[ct], bb - c0, bb - c1);
                    if (hc == qb) { const int qp = q0 + 16 * ct + n;
#pragma unroll
                        for (int i = 0; i < 4; ++i) { if (k0 + i > qp) acc[0][i] = -INFINITY; if (k0 + 4 + i > qp) acc[1][i] = -INFINITY; } }
                    const bf16x8 p = att_softmax_refm(acc[0], acc[1]); att_pv_l(st[ct], f, p); } } }
#pragma unroll
        for (int bl = 0; bl < NB; ++bl) { *(LAS v4u*)(tb + (par ^ 1) * BUFSZ + 16384 * bl + lk) = rk[bl]; *(LAS v4u*)(tb + (par ^ 1) * BUFSZ + 16384 * bl + lv) = rv[bl]; }
        if (tid < 64 * NB) *(LAS float*)(tb + (par ^ 1) * BUFSZ + CUM_OFF + 4 * tid) = rc;
        __syncthreads();
        if (kt + 1 >= nt) break;
    }
#pragma unroll
    for (int ct = 0; ct < 2; ++ct) { att_finish_l(st[ct], 1.f);
        bf16* orow = OB + (size_t)(b * T + q0 + 16 * ct + n) * DM + 1024 + h * 64 + 4 * rg;
#pragma unroll
        for (int dt = 0; dt < 4; ++dt) { v2u w; w.x = cvt_pk(st[ct].ot[dt][0], st[ct].ot[dt][1]); w.y = cvt_pk(st[ct].ot[dt][2], st[ct].ot[dt][3]); *(v2u*)(orow + 16 * dt) = w; } }
}

__device__ __forceinline__ void moba_select_unit(int b, int h, int qb, int lane, const bf16* QK, const bf16* KMH, const bf16* KML, unsigned* SEL) {
    asm volatile("" : "+v"(lane));
    const int n = lane & 15, rg = lane >> 4, q0 = 32 * qb, own = qb >> 3;
    bf16x8 qf[2][2];
#pragma unroll
    for (int ct = 0; ct < 2; ++ct)
#pragma unroll
        for (int s = 0; s < 2; ++s) qf[ct][s] = ld16(QK + (size_t)(b * T + q0 + 16 * ct + n) * NQK + C_QB + h * 64 + 32 * s + 8 * rg);
    const bf16* kh = KMH + (size_t)(b * 8 + h) * 32 * 64; const bf16* kl = KML + (size_t)(b * 8 + h) * 32 * 64;
    bf16x8 gh[2][2], gl[2][2];
    const size_t ro = (size_t)(8 * (n >> 2) + (n & 3)) * 64 + 8 * rg;
#pragma unroll
    for (int e = 0; e < 2; ++e)
#pragma unroll
        for (int s = 0; s < 2; ++s) { gh[e][s] = ld16(kh + ro + (size_t)(4 * e) * 64 + 32 * s); gl[e][s] = ld16(kl + ro + (size_t)(4 * e) * 64 + 32 * s); }
#pragma unroll
    for (int ct = 0; ct < 2; ++ct) {
        f32x4 a0 = {0.f, 0.f, 0.f, 0.f}, a1 = {0.f, 0.f, 0.f, 0.f};
#pragma unroll
        for (int s = 0; s < 2; ++s) { a0 = MFMA16(gh[0][s], qf[ct][s], a0); a1 = MFMA16(gh[1][s], qf[ct][s], a1); a0 = MFMA16(gl[0][s], qf[ct][s], a0); a1 = MFMA16(gl[1][s], qf[ct][s], a1); }
        unsigned key[8]; unsigned selm = 0u;
#pragma unroll
        for (int i = 0; i < 8; ++i) { const int kb = 8 * rg + i; const float g = i < 4 ? a0[i] : a1[i - 4]; key[i] = kb < own ? ((ord_f32(g) & ~31u) | (unsigned)(31 - kb)) : 0u; }
#pragma unroll
        for (int r = 0; r < 3; ++r) { unsigned mx = key[0];
#pragma unroll
            for (int i = 1; i < 8; ++i) mx = key[i] > mx ? key[i] : mx;
            mx = rg_max_u32(mx);
            if (mx) selm |= 1u << (31 - (mx & 31u));
#pragma unroll
            for (int i = 0; i < 8; ++i) key[i] = key[i] == mx ? 0u : key[i]; }
        if (rg == 0) SEL[(size_t)(b * 8 + h) * T + q0 + 16 * ct + n] = selm; }
}
constexpr int MG_TILE_OFF = 40960, MG_Q_OFF = 4096;
__device__ __forceinline__ void moba_gather_unit(LAS unsigned char* L, int b, int h, int j, int tid, const bf16* QK, const bf16* VT, const unsigned* SEL, bf16* PARTO, float* PARTL, const LAS float* tabs, const unsigned* KMX) {
    asm volatile("" : "+v"(tid));
    const int lane = tid & 63, wave = __builtin_amdgcn_readfirstlane(tid >> 6), n = lane & 15, rg = lane >> 4, bh = b * 8 + h;
    const LAS float* tab = tabs + (8 + h) * 32;
    LAS float* lut = (LAS float*)(L + COOP_LUT_OFF);
    for (int i = tid; i < COOP_LUT_N; i += NTHR) { const int d = i - COOP_LUT_PAD; lut[i] = d >= 0 ? tab[t5b(d)] : -INFINITY; }
    {
        const char* Kb = (const char*)(QK + (size_t)(b * T + 256 * j) * NQK + C_KB + h * 64); const char* Vb = (const char*)(VT + (size_t)(R_VB + h * 64) * M + (size_t)b * T + 256 * j);
        const bool isk = tid < 256; const int t2 = tid & 255; const int lrow = isk ? (t2 >> 3) : (t2 >> 2), lch = isk ? (t2 & 7) : (t2 & 3);
        const char* gb = isk ? Kb + (size_t)lrow * (NQK * 2) + 16 * lch : Vb + (size_t)lrow * ((size_t)M * 2) + 16 * lch; const size_t gs = isk ? (size_t)32 * NQK * 2 : (size_t)64;
        const int lofs = isk ? 128 * lrow + 16 * (lch ^ (((lrow >> 4) & 1) * 5 + ((lrow >> 1) & 1) * 2)) : 4096 + 64 * lrow + 16 * (lch ^ (3 * ((lrow >> 3) & 1)));
        v4u r[8];
#pragma unroll
        for (int t = 0; t < 8; ++t) r[t] = *(const v4u*)(gb + (size_t)t * gs);
#pragma unroll
        for (int t = 0; t < 8; ++t) *(LAS v4u*)(L + MG_TILE_OFF + 8192 * t + lofs) = r[t]; }
    __syncthreads();
    int kro[2][2], vro[4];
#pragma unroll
    for (int e = 0; e < 2; ++e) { const int rho = 8 * (n >> 2) + 4 * e + (n & 3); const int fk = ((rho >> 4) & 1) * 5 + ((rho >> 1) & 1) * 2;
#pragma unroll
        for (int s = 0; s < 2; ++s) kro[e][s] = 128 * rho + 16 * ((4 * s + rg) ^ fk); }
#pragma unroll
    for (int dt = 0; dt < 4; ++dt) { const int d = 16 * dt + n; vro[dt] = 4096 + 64 * d + 16 * (rg ^ (3 * ((d >> 3) & 1))); }
    const float kmx = sqrtf(__uint_as_float(KMX[b * 28 + h])) * 1.0001f, tmx = tabs[768 + 8 + h];
    LAS unsigned* que = (LAS unsigned*)(L + MG_Q_OFF) + wave * 128;
    auto process = [&](int nvalid) {
        bf16x8 qf[2][2]; float nref[2]; int qq[2], sl[2]; bool vld[2];
#pragma unroll
        for (int ct = 0; ct < 2; ++ct) { const int idx = 16 * ct + n; vld[ct] = idx < nvalid; const unsigned e = que[vld[ct] ? idx : 0]; qq[ct] = (int)(e & 0xffffu); sl[ct] = (int)(e >> 16);
#pragma unroll
            for (int s = 0; s < 2; ++s) qf[ct][s] = ld16(QK + (size_t)(b * T + qq[ct]) * NQK + C_QB + h * 64 + 32 * s + 8 * rg);
            nref[ct] = vld[ct] ? -(q_norm(qf[ct]) * kmx + tmx) : -INFINITY; }
        AttSt st[2]; att_init(st[0]); att_init(st[1]);
        for (int hh = 0; hh < 8; ++hh) { const LAS unsigned char* buf = L + MG_TILE_OFF + 8192 * hh; KVFrag f;
#pragma unroll
            for (int e = 0; e < 2; ++e)
#pragma unroll
                for (int s = 0; s < 2; ++s) f.k[e][s] = *(const LAS bf16x8*)(buf + kro[e][s]);
#pragma unroll
            for (int dt = 0; dt < 4; ++dt) f.v[dt] = *(const LAS bf16x8*)(buf + vro[dt]);
#pragma unroll
            for (int ct = 0; ct < 2; ++ct) { const f32x4 i0 = {nref[ct], nref[ct], nref[ct], nref[ct]}; f32x4 acc[2]; att_qk(acc, f, qf[ct], i0, i0);
                int dl = qq[ct] - (256 * j + 32 * hh + 8 * rg); dl = dl > 3000 ? 3000 : dl;
                const LAS float* lp = lut + COOP_LUT_PAD + dl - 7;
#pragma unroll
                for (int i = 0; i < 8; ++i) { const float add = lp[7 - i]; if (i < 4) acc[0][i] += add; else acc[1][i - 4] += add; }
                const bf16x8 p = att_softmax_refm(acc[0], acc[1]); att_pv_l(st[ct], f, p); } }
#pragma unroll
        for (int ct = 0; ct < 2; ++ct) { const float lt = st[ct].lv[0];
            if (vld[ct]) { const size_t pr = ((size_t)bh * T + qq[ct]) * 3 + sl[ct]; if (rg == 0) PARTL[pr] = lt;
#pragma unroll
                for (int dt = 0; dt < 4; ++dt) { v2u w; w.x = cvt_pk(st[ct].ot[dt][0], st[ct].ot[dt][1]); w.y = cvt_pk(st[ct].ot[dt][2], st[ct].ot[dt][3]); *(v2u*)(PARTO + pr * 64 + 16 * dt + 4 * rg) = w; } } } };
    int qcount = 0;
    const unsigned lowmask = (1u << j) - 1u;
    for (int q0c = 256 * (j + 1) + 64 * wave; q0c < T; q0c += 512) {
        const unsigned m = SEL[(size_t)bh * T + q0c + lane]; const bool selq = (m >> j) & 1u;
        const unsigned long long bal = __ballot(selq);
        if (selq) { const int pos = (int)__builtin_amdgcn_mbcnt_hi((unsigned)(bal >> 32), __builtin_amdgcn_mbcnt_lo((unsigned)bal, 0u)); que[qcount + pos] = (unsigned)(q0c + lane) | ((unsigned)__builtin_popcount(m & lowmask) << 16); }
        qcount += (int)__builtin_popcountll(bal);
        while (qcount >= 32) { process(32); const unsigned mv = que[lane + 32]; que[lane] = mv; qcount -= 32; }
    }
    if (qcount > 0) process(qcount);
    __syncthreads();
}

__device__ __forceinline__ void att_build_tabs(LAS float* tabs, const float* relb, int tid) {
    for (int i = tid; i < 24 * 32; i += NTHR) { const int h = i >> 5, bk = i & 31; tabs[i] = relb[bk * 24 + h] * LOG2E; }
    if (tid < 24) { float mx = -INFINITY; for (int bk = 0; bk < 32; ++bk) mx = fmaxf(mx, relb[bk * 24 + tid] * LOG2E); tabs[768 + tid] = mx; }
}
constexpr int ATT_TAB_OFF = 0, ATT_WL_OFF = 24576;

template <int MIX> __global__ void __launch_bounds__(NTHR, 2) k_att_dense(Args args) {
    extern __shared__ __attribute__((aligned(16))) unsigned char lds[];
    LAS unsigned char* L = (LAS unsigned char*)lds;
    const int tid = threadIdx.x, lane = tid & 63, wave = __builtin_amdgcn_readfirstlane(tid >> 6);
    const int gw = blockIdx.x * NWAVES + wave, NGW = gridDim.x * NWAVES;
    unsigned char* ws = args.ws;
    const bf16* QK = (const bf16*)(ws + WS_QK); const bf16* VT = (const bf16*)(ws + WS_VT); bf16* OB = (bf16*)(ws + WS_O);
    const float* CUM = (const float*)(ws + WS_CUM); const bf16* KMH = (const bf16*)(ws + WS_KMH); const bf16* KML = (const bf16*)(ws + WS_KML);
    const unsigned* KMX = (const unsigned*)(ws + WS_CTL) + CW_KMAX;
    LAS float* tabs = (LAS float*)(L + ATT_TAB_OFF);
    att_build_tabs(tabs, args.in[15], tid);
    __syncthreads();
    int k = 0;
    for (int u = gw; u < BATCH * 8 * 256; u += NGW, ++k) { const int bh = u >> 8, qi = u & 255, qb = (k & 1) ? 255 - qi : qi;
        att_dense_unit<MIX>(bh >> 3, bh & 7, qb, lane, QK, VT, CUM, KMH, KML, OB, tabs, KMX); }
}
__global__ void __launch_bounds__(NTHR, 2) k_att_nsa(Args args) {
    extern __shared__ __attribute__((aligned(16))) unsigned char lds[];
    LAS unsigned char* L = (LAS unsigned char*)lds;
    const int tid = threadIdx.x, lane = tid & 63, wave = __builtin_amdgcn_readfirstlane(tid >> 6);
    const int gw = blockIdx.x * NWAVES + wave, NGW = gridDim.x * NWAVES;
    unsigned char* ws = args.ws;
    const bf16* QK = (const bf16*)(ws + WS_QK); const bf16* VT = (const bf16*)(ws + WS_VT); bf16* OB = (bf16*)(ws + WS_O);
    const bf16* KC = (const bf16*)(ws + WS_KC); const bf16* VCT = (const bf16*)(ws + WS_VCT);
    const unsigned* KMX = (const unsigned*)(ws + WS_CTL) + CW_KMAX;
    LAS float* tabs = (LAS float*)(L + ATT_TAB_OFF);
    att_build_tabs(tabs, args.in[15], tid);
    __syncthreads();
    LAS float* wl = (LAS float*)(L + ATT_WL_OFF) + wave * NSA_WLDS;
    for (int u = gw; u < BATCH * 2 * (T / 8); u += NGW) { const int bg = u / (T / 8), t0 = (u % (T / 8)) * 8;
        att_nsa_unit(bg >> 1, bg & 1, t0, lane, QK, VT, KC, VCT, OB, tabs, wl, KMX); }
}

typedef __attribute__((address_space(4))) const Args CArgs;
__global__ void __launch_bounds__(NTHR, 2) fwd(Args args) {
    extern __shared__ __attribute__((aligned(16))) unsigned char lds[];
    LAS unsigned char* L = (LAS unsigned char*)lds;
    volatile LAS unsigned* MISC = (volatile LAS unsigned*)(L + MISC_OFF);
    const int G = gridDim.x, NGW = G * NWAVES;
#define PHASE_IDS CArgs* ap = (CArgs*)__builtin_amdgcn_kernarg_segment_ptr(); asm volatile("" : "+s"(ap)); unsigned char* ws = ap->ws; (void)ws; int tid = tid_base + (int)__builtin_amdgcn_mbcnt_hi(~0u, __builtin_amdgcn_mbcnt_lo(~0u, 0u)); asm volatile("" : "+v"(tid)); const int lane = tid & 63, wave = __builtin_amdgcn_readfirstlane(tid >> 6), gw = blockIdx.x * NWAVES + wave; (void)lane; (void)gw;
    unsigned* ctl = (unsigned*)(args.ws + WS_CTL);
    for (int u = threadIdx.x; u < (LDS_BYTES - RING_BYTES) / 4; u += NTHR) ((LAS unsigned*)(L + RING_BYTES))[u] = 0u;
    __syncthreads();
    const int lane_hw = (int)__builtin_amdgcn_mbcnt_hi(~0u, __builtin_amdgcn_mbcnt_lo(~0u, 0u));
    const unsigned simd = (unsigned)__builtin_amdgcn_s_getreg((1 << 11) | (4 << 6) | 4) & 3u;
    int tkt = 0, tks = 0;
    if (lane_hw == 0) { tkt = (int)__hip_atomic_fetch_add((LAS unsigned*)(L + MISC_OFF) + 12, 1u, __ATOMIC_RELAXED, __HIP_MEMORY_SCOPE_WORKGROUP);
                        tks = (int)__hip_atomic_fetch_add((LAS unsigned*)(L + MISC_OFF) + 16 + simd, 1u, __ATOMIC_RELAXED, __HIP_MEMORY_SCOPE_WORKGROUP); }
    __syncthreads();
    const bool two_each = MISC[16] == 2u && MISC[17] == 2u && MISC[18] == 2u && MISC[19] == 2u;
    const int slot = (int)(((simd & 1u) << 1) | (simd >> 1));
    const int tid_base = 64 * (two_each ? slot + 4 * __builtin_amdgcn_readfirstlane(tks) : __builtin_amdgcn_readfirstlane(tkt));
    XcdBarrier bar = xcd_barrier_post(ctl + CW_BAR, MISC + 8, (tid_base == 0 && lane_hw == 0) ? 1 : 0);
    const int lo = args.ph_lo, hi = args.ph_hi;
#define IN(k) (lo <= (k) && (k) < hi)
#define SEAM(k) do { if (IN(k) && IN((k) + 1)) xcd_barrier(bar); } while (0)
#define PTRS bf16* XN = (bf16*)(ws + WS_XN); bf16* Y = (bf16*)(ws + WS_Y); bf16* QK = (bf16*)(ws + WS_QK); bf16* VT = (bf16*)(ws + WS_VT); bf16* OB = (bf16*)(ws + WS_O); bf16* H = (bf16*)(ws + WS_H); \
    bf16* KCb = (bf16*)(ws + WS_KC); float* CUM = (float*)(ws + WS_CUM); (void)XN; (void)Y; (void)QK; (void)VT; (void)OB; (void)H; (void)KCb; (void)CUM;
    if (IN(0)) {
        PHASE_IDS PTRS
        LAS float* scr = (LAS float*)(L + wave * 16384);
        constexpr int I_QK = 32 * (NQK / 32), I_V = 32 * (NV / 32), I_OUT = 32 * (DM / 32), I_UP = 32 * (DFF / 32), I_DOWN = (DFF / 64) * (DM / 32);
        constexpr int I_LAYER = I_QK + I_V + I_OUT + I_UP + I_DOWN;
        for (int rep = 0; rep < P0_REP; ++rep) {
        for (int it = gw; it < DEPTH * I_LAYER; it += NGW) {
            const int l = it / I_LAYER; int r = it % I_LAYER;
            unsigned char* wl = ws + WS_W + (size_t)l * W_LAYER;
            if (r < I_QK) { transpose_item<1>(ap->in[1] + (size_t)l * DM * PW, DM, PW, (bf16*)(wl + WO_QK), NQK, scr, r, lane, ap->in[3] + (size_t)l * DM); continue; } r -= I_QK;
            if (r < I_V) { transpose_item<2>(ap->in[1] + (size_t)l * DM * PW, DM, PW, (bf16*)(wl + WO_V), NV, scr, r, lane, ap->in[3] + (size_t)l * DM); continue; } r -= I_V;
            if (r < I_OUT) { transpose_item<0>(ap->in[2] + (size_t)l * DM * DM, DM, DM, (bf16*)(wl + WO_OUT), DM, scr, r, lane); continue; } r -= I_OUT;
            if (r < I_UP) { transpose_item<0>(ap->in[7] + (size_t)l * DM * DFF, DM, DFF, (bf16*)(wl + WO_UP), DFF, scr, r, lane, ap->in[5] + (size_t)l * DM); continue; } r -= I_UP;
            transpose_item<0>(ap->in[8] + (size_t)l * DFF * DM, DFF, DM, (bf16*)(wl + WO_DOWN), DM, scr, r, lane);
        }
        for (int it = gw; it < DEPTH * 2 * (256 + 8); it += NGW) { const int l = it / (2 * 264), r = it % (2 * 264), which = r / 264, q = r % 264;
            unsigned char* wl = ws + WS_W + (size_t)l * W_LAYER; unsigned char* sw = ws + WS_SW + (size_t)l * SW_LAYER;
            if (q < 256) transpose_item<0>(ap->in[which ? 12 : 10] + (size_t)l * 2048 * 256, 2048, 256, (bf16*)(wl + (which ? WO_W1V : WO_W1K)), 256, scr, q, lane);
            else transpose_item<0>(ap->in[which ? 13 : 11] + (size_t)l * 256 * 64, 256, 64, (bf16*)(sw + (which ? SW_W2V : SW_W2K)), 64, scr, q - 256, lane); }
        for (int it = gw; it < DEPTH * 2 * 256; it += NGW) { const int l = it >> 9, which = (it >> 8) & 1, nn = it & 255;
            const float* pe = ap->in[9] + (size_t)l * 2048; const float* w1 = ap->in[which ? 12 : 10] + (size_t)l * 2048 * 256 + nn; float a = 0.f;
            for (int k = lane; k < 2048; k += 64) a += pe[k] * w1[(size_t)k * 256];
            a = wave_sum(a); if (lane == 0) ((float*)(ws + WS_SW + (size_t)l * SW_LAYER + SW_HB))[which * 256 + nn] = a; }
        for (int m = gw; m < M; m += NGW) norm_pre_row(ap->in[0] + (size_t)m * DM, XN + (size_t)m * DM, (float*)(ws + WS_RSTD) + m, lane);
        for (int i = gw * 64 + lane; i < DEPTH * 2 * 2 * M; i += NGW * 64) ((unsigned long long*)(ws + WS_SSQ))[i] = 0ull;
        }
    }
    SEAM(0);

    auto layer = [&](auto LC) __attribute__((always_inline)) -> void {
        constexpr int l = decltype(LC)::value;
        const int pb = 1 + 7 * l;
        if (IN(pb + 0)) {
            PHASE_IDS PTRS (void)tid;
            unsigned char* wl = ws + WS_W + (size_t)l * W_LAYER;
            { pg8::Gemm g{XN, (const bf16*)(wl + WO_QK), M, NQK, DM}; pg8::StaticOrder S; S.init(M, NQK, G, (int)blockIdx.x);
              const void* rsp = l == 0 ? (const void*)(ws + WS_RSTD) : (const void*)((const unsigned long long*)(ws + WS_SSQ) + (size_t)(((l - 1) * 2 + 1) * 2 + 1) * M);
              pg8::EpiBf16<0, 1, (l > 0)> E{QK, NQK, rsp}; pg8::gemm_phase<pg8::EpiBf16<0, 1, (l > 0)>, pg8::StaticOrder, false, true>(L, g, S, E, tid); }
            { pg8::Gemm g{(const bf16*)(wl + WO_V), XN, NV, M, DM}; pg8::StaticOrder S; S.init(NV, M, G, (int)blockIdx.x);
              const void* rsp = l == 0 ? (const void*)(ws + WS_RSTD) : (const void*)((const unsigned long long*)(ws + WS_SSQ) + (size_t)(((l - 1) * 2 + 1) * 2 + 1) * M);
              pg8::EpiBf16<0, 2, (l > 0)> E{VT, M, rsp}; pg8::gemm_phase<pg8::EpiBf16<0, 2, (l > 0)>, pg8::StaticOrder, false, true>(L, g, S, E, tid); }
        }
        SEAM(pb + 0);
        if (IN(pb + 1)) {
            PHASE_IDS PTRS
            unsigned char* wl = ws + WS_W + (size_t)l * W_LAYER;
            const unsigned char* sw = ws + WS_SW + (size_t)l * SW_LAYER;
            for (int rep = 0; rep < PRE_REP; ++rep) {
            for (int u = blockIdx.x; u < 256; u += G) { const int which = u >> 7, bg = (u >> 4) & 7, cb = u & 15;
                compress_unit(L, which, bg, cb, QK, (const bf16*)(wl + (which ? WO_W1V : WO_W1K)), (const bf16*)(sw + (which ? SW_W2V : SW_W2K)), (const float*)(sw + SW_HB) + which * 256, KCb, (bf16*)(ws + WS_VCT), wave, lane); }
            for (int u = gw; u < BATCH * 8 * 32; u += NGW) { const int bh = u >> 5, kb = u & 31, b = bh >> 3, h = bh & 7;
                const int rsub = lane >> 3, c8 = lane & 7; const bf16* p = QK + (size_t)(b * T + kb * 256 + rsub) * NQK + C_KB + h * 64 + 8 * c8;
                float s8[8] = {0.f, 0.f, 0.f, 0.f, 0.f, 0.f, 0.f, 0.f};
#pragma unroll 8
                for (int it = 0; it < 32; ++it) { const v4u w = *(const v4u*)(p + (size_t)(8 * it) * NQK);
                    s8[0] += bf_lo(w.x); s8[1] += bf_hi(w.x); s8[2] += bf_lo(w.y); s8[3] += bf_hi(w.y); s8[4] += bf_lo(w.z); s8[5] += bf_hi(w.z); s8[6] += bf_lo(w.w); s8[7] += bf_hi(w.w); }
                unsigned hb[8], lb[8];
#pragma unroll
                for (int k = 0; k < 8; ++k) { float v = s8[k]; v += __shfl_xor(v, 8); v += __shfl_xor(v, 16); v += __shfl_xor(v, 32); const float km = v * (1.f / 256.f); hb[k] = f2bf(km); lb[k] = f2bf(km - bf_lo(hb[k])); }
                if (rsub == 0) { v4u oh, ol; oh.x = hb[0] | (hb[1] << 16); oh.y = hb[2] | (hb[3] << 16); oh.z = hb[4] | (hb[5] << 16); oh.w = hb[6] | (hb[7] << 16);
                    ol.x = lb[0] | (lb[1] << 16); ol.y = lb[2] | (lb[3] << 16); ol.z = lb[4] | (lb[5] << 16); ol.w = lb[6] | (lb[7] << 16);
                    *(v4u*)((bf16*)(ws + WS_KMH) + (size_t)u * 64 + 8 * c8) = oh; *(v4u*)((bf16*)(ws + WS_KML) + (size_t)u * 64 + 8 * c8) = ol; } }
            for (int u = gw; u < BATCH * 28 * (T / 64); u += NGW) { const int b = u / (28 * (T / 64)), r = u % (28 * (T / 64)), hk = r / (T / 64), ch = r % (T / 64);
                const int col = hk < 8 ? C_KB + hk * 64 : (hk < 16 ? C_KC + (hk - 8) * 64 : (hk < 24 ? C_KD + (hk - 16) * 64 : (hk < 26 ? C_KSA + (hk - 24) * 64 : C_KWA + (hk - 26) * 64)));
                const v4u* rp = (const v4u*)(QK + (size_t)(b * T + ch * 64 + lane) * NQK + col); float sq = 0.f;
#pragma unroll
                for (int i = 0; i < 8; ++i) { const v4u w = rp[i]; sq += bf_lo(w.x) * bf_lo(w.x) + bf_hi(w.x) * bf_hi(w.x) + bf_lo(w.y) * bf_lo(w.y) + bf_hi(w.y) * bf_hi(w.y) + bf_lo(w.z) * bf_lo(w.z) + bf_hi(w.z) * bf_hi(w.z) + bf_lo(w.w) * bf_lo(w.w) + bf_hi(w.w) * bf_hi(w.w); }
                sq = wave_max(sq);
                if (lane == 0) atomicMax((unsigned*)(ws + WS_CTL) + CW_KMAX + l * 112 + b * 28 + hk, __float_as_uint(sq)); }
            {
                bf16* VDFw = (bf16*)(ws + WS_VDF);
                for (int it = gw * 64 + lane; it < BATCH * 512 * 64; it += NGW * 64) { const int k8 = it & 63, row = (it >> 6) & 511, b2 = it >> 15;
                    const v4u* src = (const v4u*)(VT + (size_t)(R_VD + row) * M + (size_t)b2 * T + 128 * k8);
                    bf16* dst = VDFw + ((size_t)(b2 * 512 + row) * 16) * 512 + 8 * k8;
#pragma unroll
                    for (int ph = 0; ph < 2; ++ph) { v4u w[8];
#pragma unroll
                        for (int kk = 0; kk < 8; ++kk) w[kk] = src[2 * kk + ph];
#pragma unroll
                        for (int j = 0; j < 8; ++j) { unsigned e[8];
#pragma unroll
                            for (int kk = 0; kk < 8; ++kk) { const unsigned d = (j >> 1) == 0 ? w[kk].x : ((j >> 1) == 1 ? w[kk].y : ((j >> 1) == 2 ? w[kk].z : w[kk].w)); e[kk] = (j & 1) ? (d >> 16) : (d & 0xffffu); }
                            v4u o; o.x = e[0] | (e[1] << 16); o.y = e[2] | (e[3] << 16); o.z = e[4] | (e[5] << 16); o.w = e[6] | (e[7] << 16);
                            *(v4u*)(dst + (size_t)(8 * ph + j) * 512) = o; } } } }
            for (int u = blockIdx.x; u < BATCH * 8; u += G) { const int b = u >> 3, h = u & 7;
                cumsum_unit(L, VT + (size_t)(R_FC + h) * M + (size_t)b * T, ap->in[14][l * 8 + h], CUM + (size_t)u * T, tid); }
            }
        }
        SEAM(pb + 1);
        if (IN(pb + 2)) {
            PHASE_IDS PTRS
            LAS float* tabs = (LAS float*)(L + ATT_TAB_OFF);
            att_build_tabs(tabs, ap->in[15], tid);
            __syncthreads();
            const bf16* KMH = (const bf16*)(ws + WS_KMH); const bf16* KML = (const bf16*)(ws + WS_KML); const bf16* VCT = (const bf16*)(ws + WS_VCT);
            const unsigned* KMX = (const unsigned*)(ws + WS_CTL) + CW_KMAX + l * 112;
            const int vcu = (G % 8 == 0) ? ((int)blockIdx.x % 8) * (G / 8) + (int)blockIdx.x / 8 : (int)blockIdx.x;
            {
                constexpr int Q_SEL = BATCH * 8 * 32, Q_NSA = Q_SEL + BATCH * 2 * (T / 64), Q_FOX = Q_NSA + BATCH * 8 * 32, Q_G0 = Q_FOX + 8 * BATCH * 8, Q_D = Q_G0 + BATCH * 8 * 32, Q_END = Q_D + 23 * BATCH * 8;
                unsigned* qctr = (unsigned*)(ws + WS_CTL) + CW_Q + 2 * l; unsigned* seldone = qctr + 1; int lastg = -1; bool sel_ready = false;
                for (;;) {
                    __syncthreads();
                    if (tid == 0) MISC[20] = __hip_atomic_fetch_add(qctr, 1u, __ATOMIC_RELAXED, __HIP_MEMORY_SCOPE_AGENT);
                    __syncthreads();
                    const int i = (int)MISC[20];
                    if (i >= Q_END) break;
                    if (i < Q_SEL) { const int u = i * NWAVES + wave, bh = u >> 8, qb = u & 255; moba_select_unit(bh >> 3, bh & 7, qb, lane, QK, KMH, KML, (unsigned*)(ws + WS_SEL));
                        asm volatile("s_waitcnt vmcnt(0)" ::: "memory"); __syncthreads();
                        if (tid == 0) { __builtin_amdgcn_fence(__ATOMIC_RELEASE, "agent"); asm volatile("s_waitcnt vmcnt(0)" ::: "memory"); (void)__hip_atomic_fetch_add(seldone, 1u, __ATOMIC_RELAXED, __HIP_MEMORY_SCOPE_AGENT); } }
                    else if (i < Q_NSA) { const int i1 = i - Q_SEL, bg = i1 & 7, t0 = (T / 64 - 1 - (i1 >> 3)) * 64;
                        if ((bg & 1) != lastg) { nsa_build_lut(L, tabs, bg & 1, tid); lastg = bg & 1; __syncthreads(); }
                        att_nsa_coop_unit(L, bg >> 1, bg & 1, t0, tid, QK, VT, KCb, VCT, OB, tabs, KMX); }
                    else if (i < Q_FOX) { const int i2 = i - Q_NSA, bh = i2 & 31, uq = 31 - (i2 >> 5); lastg = -1;
                        att_fox_unit<FOX_NB>(L, bh >> 3, bh & 7, uq, tid, QK, VT, CUM, OB, KMX); }
                    else if (i >= Q_G0 && i < Q_D) { const int i4 = i - Q_G0, bh = i4 >> 5, uq = i4 & 31; lastg = -1;
                        att_coop_unit<1>(L, bh >> 3, bh & 7, uq, tid, QK, VT, CUM, KMH, KML, OB, tabs, KMX, (const bf16*)(ws + WS_VDF)); }
                    else { const int i3 = i < Q_G0 ? i - Q_FOX : i - Q_D + 8 * BATCH * 8, j = i3 / (BATCH * 8), bh = i3 % (BATCH * 8); lastg = -1;
                        if (!sel_ready) {
                            if (tid == 0) { XB_SPIN(xb_ld(seldone) < (unsigned)Q_SEL, (unsigned*)(ws + WS_CTL) + CW_BAR); __builtin_amdgcn_fence(__ATOMIC_ACQUIRE, "agent"); asm volatile("s_waitcnt vmcnt(0)" ::: "memory"); }
                            __syncthreads(); sel_ready = true; }
                        moba_gather_unit(L, bh >> 3, bh & 7, j, tid, QK, VT, (const unsigned*)(ws + WS_SEL), (bf16*)(ws + WS_PARTO), (float*)(ws + WS_PARTL), tabs, KMX); } } }
            __syncthreads();
        }
        SEAM(pb + 2);
        if (IN(pb + 3)) {
            PHASE_IDS PTRS
            LAS float* tabs = (LAS float*)(L + ATT_TAB_OFF);
            att_build_tabs(tabs, ap->in[15], tid);
            __syncthreads();
            const bf16* KMH = (const bf16*)(ws + WS_KMH); const bf16* KML = (const bf16*)(ws + WS_KML);
            const unsigned* KMX = (const unsigned*)(ws + WS_CTL) + CW_KMAX + l * 112;
            const int vcu = (G % 8 == 0) ? ((int)blockIdx.x % 8) * (G / 8) + (int)blockIdx.x / 8 : (int)blockIdx.x;
            for (int u = vcu; u < BATCH * 8 * 32; u += G) { const int bh = u >> 5, uq = u & 31;
                att_coop_unit<3>(L, bh >> 3, bh & 7, uq, tid, QK, VT, CUM, KMH, KML, OB, tabs, KMX, nullptr, (const bf16*)(ws + WS_PARTO), (const float*)(ws + WS_PARTL)); }
            __syncthreads();
        }
        SEAM(pb + 3);
        if (IN(pb + 4)) {
            PHASE_IDS PTRS (void)tid;
            unsigned char* wl = ws + WS_W + (size_t)l * W_LAYER;
            pg8::Gemm g{OB, (const bf16*)(wl + WO_OUT), M, DM, DM}; pg8::PanelOrder S; S.init((int)blockIdx.x);
            unsigned long long* ssq = (unsigned long long*)(ws + WS_SSQ) + (size_t)((l * 2 + 0) * 2) * M;
            pg8::EpiNormRes<false> E{XN, ap->in[4] + (size_t)l * DM, ssq, ssq + M, (unsigned*)(ws + WS_CTL) + CW_NC + (l * 2 + 0) * 256, nullptr};
            pg8::gemm_phase<pg8::EpiNormRes<false>, pg8::PanelOrder, true, true>(L, g, S, E, tid);
        }
        SEAM(pb + 4);
        if (IN(pb + 5)) {
            PHASE_IDS PTRS (void)tid;
            unsigned char* wl = ws + WS_W + (size_t)l * W_LAYER;
            pg8::Gemm g{XN, (const bf16*)(wl + WO_UP), M, DFF, DM}; pg8::StaticOrder S; S.init(M, DFF, G, (int)blockIdx.x);
            pg8::EpiBf16<2, 1, true> E{H, DFF, (const void*)((const unsigned long long*)(ws + WS_SSQ) + (size_t)((l * 2 + 0) * 2 + 1) * M)}; pg8::gemm_phase<pg8::EpiBf16<2, 1, true>, pg8::StaticOrder, false, true>(L, g, S, E, tid);
        }
        SEAM(pb + 5);
        if (IN(pb + 6)) {
            PHASE_IDS PTRS (void)tid;
            unsigned char* wl = ws + WS_W + (size_t)l * W_LAYER;
            pg8::Gemm g{H, (const bf16*)(wl + WO_DOWN), M, DM, DFF}; pg8::PanelOrder S; S.init((int)blockIdx.x);
            unsigned long long* ssq = (unsigned long long*)(ws + WS_SSQ) + (size_t)((l * 2 + 1) * 2) * M;
            pg8::EpiNormRes<(l + 1 == DEPTH)> E{XN, ap->in[6] + (size_t)l * DM, ssq, ssq + M, (unsigned*)(ws + WS_CTL) + CW_NC + (l * 2 + 1) * 256, ap->out};
            pg8::gemm_phase<pg8::EpiNormRes<(l + 1 == DEPTH)>, pg8::PanelOrder, true, true>(L, g, S, E, tid);
        }
        SEAM(pb + 6);
    };
    layer(std::integral_constant<int, 0>{});
    layer(std::integral_constant<int, 1>{});
    static_assert(DEPTH == 2, "two layer instantiations");
#undef IN
#undef SEAM
}

constexpr int N_PHASES = 1 + 7 * DEPTH;
extern "C" void kernel_launch(void* const* d_in, const int* in_sizes, int n_in, void* d_out, int out_size, void* d_ws, size_t ws_size, hipStream_t stream) {
    static int grid = 0;
    if (grid == 0) {
        if (n_in != 16 || in_sizes[0] != M * DM || out_size != M * DM || ws_size < WS_END + 34 * MiB) { fprintf(stderr, "kernel_launch: unexpected shapes / workspace (n_in %d, ws %zu, need %zu)\n", n_in, ws_size, (size_t)WS_END); grid = -1; return; }
        int dev = 0, cus = 0;
        if (hipGetDevice(&dev) != hipSuccess || hipDeviceGetAttribute(&cus, hipDeviceAttributeMultiprocessorCount, dev) != hipSuccess) { grid = -1; return; }
        (void)hipFuncSetAttribute((const void*)k_att_dense<0>, hipFuncAttributeMaxDynamicSharedMemorySize, LDS_BYTES); (void)hipFuncSetAttribute((const void*)k_att_dense<1>, hipFuncAttributeMaxDynamicSharedMemorySize, LDS_BYTES);
        (void)hipFuncSetAttribute((const void*)k_att_dense<2>, hipFuncAttributeMaxDynamicSharedMemorySize, LDS_BYTES); (void)hipFuncSetAttribute((const void*)k_att_nsa, hipFuncAttributeMaxDynamicSharedMemorySize, LDS_BYTES);
        if (hipFuncSetAttribute((const void*)fwd, hipFuncAttributeMaxDynamicSharedMemorySize, LDS_BYTES) != hipSuccess) { fprintf(stderr, "kernel_launch: hipFuncSetAttribute failed\n"); grid = -1; return; }
        int per_cu = 0;
        if (hipOccupancyMaxActiveBlocksPerMultiprocessor(&per_cu, (const void*)fwd, NTHR, LDS_BYTES) != hipSuccess || per_cu < 1) fprintf(stderr, "kernel_launch: occupancy query says %d\n", per_cu);
        (void)hipGetLastError();
        if (cus != 256) { fprintf(stderr, "kernel_launch: the fused residual epilogues are laid out for 256 CUs (found %d)\n", cus); grid = -1; return; }
        grid = cus;
    }
    if (grid < 0) return;
    (void)hipMemsetAsync((char*)d_ws + WS_CTL, 0, CTL_ZERO_BYTES, stream);
    Args a{};
    for (int i = 0; i < 16; ++i) a.in[i] = (const float*)d_in[i];
    a.out = (float*)d_out; a.ws = (unsigned char*)d_ws;
#if N_LAUNCH_PER_PHASE
    for (int p = 0; p < N_PHASES; ++p) {
        const int l = (p - 1) / 8, j = (p - 1) % 8;
#if defined(NAIVE_ATT) && !defined(FUSED_ATT)
        if (p >= 1 && j == 1) { hipLaunchKernelGGL(k_naive_vn, dim3(4096), dim3(256), 0, stream, a); hipLaunchKernelGGL(k_naive_pre, dim3(2048), dim3(256), 0, stream, a, l); continue; }
#if defined(FAST_ATT) && !defined(FUSED_ATT)
        if (p >= 1 && j == 2) { hipLaunchKernelGGL(k_att_dense<0>, dim3(grid), dim3(NTHR), LDS_BYTES, stream, a); hipLaunchKernelGGL(k_att_dense<1>, dim3(grid), dim3(NTHR), LDS_BYTES, stream, a); hipLaunchKernelGGL(k_att_dense<2>, dim3(grid), dim3(NTHR), LDS_BYTES, stream, a); hipLaunchKernelGGL(k_att_nsa, dim3(grid), dim3(NTHR), LDS_BYTES, stream, a); continue; }
#endif
        if (p >= 1 && j == 2) { hipLaunchKernelGGL(k_naive_bcd<0>, dim3(4096), dim3(256), 0, stream, a, l); hipLaunchKernelGGL(k_naive_bcd<1>, dim3(4096), dim3(256), 0, stream, a, l); hipLaunchKernelGGL(k_naive_bcd<2>, dim3(4096), dim3(256), 0, stream, a, l); hipLaunchKernelGGL(k_naive_nsa, dim3(1024), dim3(256), 0, stream, a, l); continue; }
#endif
        a.ph_lo = p; a.ph_hi = p + 1; hipLaunchKernelGGL(fwd, dim3(grid), dim3(NTHR), LDS_BYTES, stream, a); }
#else
    a.ph_lo = 0; a.ph_hi = N_PHASES; hipLaunchKernelGGL(fwd, dim3(grid), dim3(NTHR), LDS_BYTES, stream, a);
#endif
}
```

```cpp
#include <hip/hip_runtime.h>
#include <cstdio>
#include <cstdint>
#include <type_traits>
#define FUSED_ATT 1
#define N_LAUNCH_PER_PHASE 0
#ifndef REP_MOBA
#define REP_MOBA 1
#endif
#ifndef REP_FOX
#define REP_FOX 1
#endif
#ifndef REP_NSA
#define REP_NSA 1
#endif
#ifndef REP_D
#define REP_D 1
#endif
#ifndef ATT_REP
#define ATT_REP 1
#endif
#ifndef FOX_NB
#define FOX_NB 2
#endif
#ifndef FOX_NQ
#define FOX_NQ 4
#endif
#ifndef GEMM_REP
#define GEMM_REP 1
#endif
#ifndef PRE_REP
#define PRE_REP 1
#endif
#ifndef P0_REP
#define P0_REP 1
#endif
namespace pg8 {
#define PG8_LAS __attribute__((address_space(3)))
typedef unsigned short bf16_t;
typedef short bf16x8 __attribute__((ext_vector_type(8)));
typedef float f32x4 __attribute__((ext_vector_type(4)));
typedef unsigned u32x4 __attribute__((ext_vector_type(4)));
constexpr int BM = 256, BK = 64, HALF = 128, HTB = HALF * BK * 2  , STAGE_BYTES = 8 * HTB, NXCD = 8, WGM = 8;

__host__ __device__ __forceinline__ int lds_byte(int r, int c) { const int st = (r >> 4) * 2 + (c >> 5), rr = r & 15, cc = c & 31, ob = rr * 64 + cc * 2; return st * 1024 + (ob ^ (((ob >> 9) & 1) << 5)); }
__host__ __device__ __forceinline__ void stage_rc(int b, int& R, int& C) { const int st = b / 1024, sb = b % 1024, swz = sb ^ (((sb >> 9) & 1) << 5); R = (st >> 1) * 16 + swz / 64; C = (st & 1) * 32 + (swz % 64) / 2; }
__host__ __device__ __forceinline__ int perm32(int rho) { const int n = rho >> 4, i = rho & 15; return 8 * (i >> 2) + 4 * n + (i & 3); }

struct Unit { int pm, pn; };
struct Gemm { const bf16_t* A; const bf16_t* Bt; int M, N, K; };

struct StaticOrder {
    int nM, nN, nwg, G, c;
    __host__ __device__ void init(int M, int N, int G_, int c_) { nM = M / BM; nN = N / BM; nwg = nM * nN; G = G_; c = c_; }
    __host__ __device__ bool next(int i, Unit& u) const {
        const long L = (long)i * G + c; if (L >= nwg) return false;
        int wgid = (int)L; { const int q = nwg / NXCD, r = nwg % NXCD, xcd = wgid % NXCD, off = wgid / NXCD; wgid = (xcd < r ? xcd * (q + 1) : r * (q + 1) + (xcd - r) * q) + off; }
        const int nig = WGM * nN, gid = wgid / nig, fm = gid * WGM, gsz = (nM - fm) < WGM ? (nM - fm) : WGM;
        u.pm = fm + ((wgid % nig) % gsz); u.pn = (wgid % nig) / gsz; return true;
    }
    __device__ __forceinline__ void a_ready(const Unit&) const {}
    __device__ __forceinline__ void done(const Unit&) const {}
};

typedef __bf16 bf16x2_cv __attribute__((ext_vector_type(2)));
typedef float f32x2_cv __attribute__((ext_vector_type(2)));
__device__ __forceinline__ unsigned cvt_pk_bf16(float lo, float hi) { const f32x2_cv v = {lo, hi}; return __builtin_bit_cast(unsigned, __builtin_convertvector(v, bf16x2_cv)); }
typedef float f32x2 __attribute__((ext_vector_type(2)));
__device__ __forceinline__ float rstd_of_sum(unsigned long long s) { return __builtin_amdgcn_rsqf((float)s * (1.f / 16777216.f) * (1.f / 2048.f) + 1e-6f); }
template <int ACT, int SCL = 0, bool SQ = false, bool KN = false> struct EpiBf16 {
    static constexpr bool PERM = true, AFTER_DRAIN = false;
    bf16_t* O; int ldc; const void* rsv; unsigned* k2;
    __device__ __forceinline__ void operator()(const f32x4 (&acc)[2][2][4][2], const Unit& u, int wr, int wc, int fr, int fq) const {
        const int row0 = u.pm * BM + wr * 64 + fr; const int col0 = u.pn * BM + wc * 32 + 8 * fq;
        const float* rs = (const float*)rsv; const unsigned long long* sq = (const unsigned long long*)rsv;
        float kmx2[2] = {0.f, 0.f};
        f32x4 cs[2][2];
        if (SCL == 2) {
#pragma unroll
            for (int bj = 0; bj < 2; ++bj) {
                if (SQ) {
#pragma unroll
                    for (int e = 0; e < 4; ++e) { cs[bj][0][e] = rstd_of_sum(sq[col0 + bj * HALF + e]); cs[bj][1][e] = rstd_of_sum(sq[col0 + bj * HALF + 4 + e]); } }
                else { cs[bj][0] = *(const f32x4*)(rs + col0 + bj * HALF); cs[bj][1] = *(const f32x4*)(rs + col0 + bj * HALF + 4); } } }
#pragma unroll
        for (int ai = 0; ai < 2; ++ai)
#pragma unroll
            for (int m = 0; m < 4; ++m) { bf16_t* rowp = O + (size_t)(row0 + ai * HALF + m * 16) * ldc + col0;
                const float rsc = SCL == 1 ? (SQ ? rstd_of_sum(sq[row0 + ai * HALF + m * 16]) : rs[row0 + ai * HALF + m * 16]) : 1.f;
#pragma unroll
                for (int bj = 0; bj < 2; ++bj) { f32x4 v0 = acc[ai][bj][m][0], v1 = acc[ai][bj][m][1];
                    if (SCL == 1) { v0 = v0 * rsc; v1 = v1 * rsc; }
                    if (SCL == 2) { v0 = v0 * cs[bj][0]; v1 = v1 * cs[bj][1]; }
                    if (KN) { float s8 = ((v0[0] * v0[0] + v0[1] * v0[1]) + (v0[2] * v0[2] + v0[3] * v0[3])) + ((v1[0] * v1[0] + v1[1] * v1[1]) + (v1[2] * v1[2] + v1[3] * v1[3]));
                        s8 += __shfl_xor(s8, 16); s8 += __shfl_xor(s8, 32); kmx2[bj] = fmaxf(kmx2[bj], s8); }
                    if (ACT == 2) {
#pragma unroll
                        for (int e = 0; e < 4; ++e) { float a = v0[e] > 0.f ? v0[e] : 0.f; v0[e] = a * a; float b = v1[e] > 0.f ? v1[e] : 0.f; v1[e] = b * b; }
                    }
                    u32x4 w; w.x = cvt_pk_bf16(v0[0], v0[1]); w.y = cvt_pk_bf16(v0[2], v0[3]); w.z = cvt_pk_bf16(v1[0], v1[1]); w.w = cvt_pk_bf16(v1[2], v1[3]);
                    if (ACT == 2) __builtin_nontemporal_store(w, (u32x4*)(rowp + bj * HALF)); else *(u32x4*)(rowp + bj * HALF) = w; } }
        if (KN) {
#pragma unroll
            for (int bj = 0; bj < 2; ++bj) { const int cb = (u.pn * BM + bj * HALF + wc * 32) >> 6;
                const int hk = (cb >= 12 && cb < 14) ? 24 + (cb - 12) : (cb >= 14 && cb < 16) ? 26 + (cb - 14) : (cb >= 24 && cb < 32) ? cb - 24 : (cb >= 40 && cb < 48) ? 8 + (cb - 40) : (cb >= 56) ? 16 + (cb - 56) : -1;
                if (hk >= 0) { float mx = kmx2[bj]; mx = fmaxf(mx, __shfl_xor(mx, 1)); mx = fmaxf(mx, __shfl_xor(mx, 2)); mx = fmaxf(mx, __shfl_xor(mx, 4)); mx = fmaxf(mx, __shfl_xor(mx, 8));
                    if (fr == 0 && fq == 0) atomicMax(k2 + (((u.pm * BM) >> 13) * 28 + hk) * 2 + (wc & 1), __float_as_uint(mx)); } } }
    }
};

struct PanelOrder {
    int c;
    __host__ __device__ void init(int c_) { c = c_; }
    __host__ __device__ bool next(int i, Unit& u) const { if (i >= 4) return false; const int x = c & 7, j = c >> 3; u.pm = (i * 4 + (j >> 3)) * 8 + x; u.pn = j & 7; return true; }
    __device__ __forceinline__ void a_ready(const Unit&) const {}
    __device__ __forceinline__ void done(const Unit&) const {}
};
template <bool FINAL> struct EpiNormRes {
    static constexpr bool PERM = true, AFTER_DRAIN = false;
    static constexpr int ND = 2048; static constexpr float FXS = 16777216.f, EPSN = 1e-6f;
    bf16_t* X; const float* gpost; unsigned long long* SA; unsigned long long* SB; unsigned* cnt; float* fout;
    static __device__ __forceinline__ void spin64(unsigned* p) { unsigned sp = 0; while (__hip_atomic_load(p, __ATOMIC_RELAXED, __HIP_MEMORY_SCOPE_AGENT) < 64u) { __builtin_amdgcn_s_sleep(1); if (++sp > (1u << 22)) break; } }
    __device__ __forceinline__ void operator()(const f32x4 (&acc)[2][2][4][2], const Unit& u, int wr, int wc, int fr, int fq) const {
        const int row0 = u.pm * BM + wr * 64 + fr; const int col0 = u.pn * BM + wc * 32 + 8 * fq;
#pragma unroll
        for (int ai = 0; ai < 2; ++ai)
#pragma unroll
            for (int m = 0; m < 4; ++m) { float t = 0.f;
#pragma unroll
                for (int bj = 0; bj < 2; ++bj)
#pragma unroll
                    for (int n = 0; n < 2; ++n) { const f32x4 v = acc[ai][bj][m][n]; t += (v[0] * v[0] + v[1] * v[1]) + (v[2] * v[2] + v[3] * v[3]); }
                t += __shfl_xor(t, 16); t += __shfl_xor(t, 32);
                if (fq == 0) (void)__hip_atomic_fetch_add(SA + row0 + ai * HALF + m * 16, (unsigned long long)(t * FXS), __ATOMIC_RELAXED, __HIP_MEMORY_SCOPE_AGENT); }
        asm volatile("s_waitcnt vmcnt(0)" ::: "memory");
        __builtin_amdgcn_s_barrier();
        if (wr == 0 && wc == 0 && fr == 0 && fq == 0) {
            (void)__hip_atomic_fetch_add(cnt + 2 * u.pm, 1u, __ATOMIC_RELAXED, __HIP_MEMORY_SCOPE_AGENT);
            unsigned sp = 0; while (__hip_atomic_load(cnt + 2 * u.pm, __ATOMIC_RELAXED, __HIP_MEMORY_SCOPE_AGENT) < 8u) { __builtin_amdgcn_s_sleep(8); if (++sp > (1u << 20)) break; } }
        __builtin_amdgcn_s_barrier();
        float ry[2][4];
        {   unsigned long long sv[2][4];
#pragma unroll
            for (int ai = 0; ai < 2; ++ai)
#pragma unroll
                for (int m = 0; m < 4; ++m) sv[ai][m] = __hip_atomic_load(SA + row0 + ai * HALF + m * 16, __ATOMIC_RELAXED, __HIP_MEMORY_SCOPE_AGENT);
#pragma unroll
            for (int ai = 0; ai < 2; ++ai)
#pragma unroll
                for (int m = 0; m < 4; ++m) ry[ai][m] = __builtin_amdgcn_rsqf((float)sv[ai][m] * (1.f / FXS) * (1.f / ND) + EPSN); }
        f32x4 gg[2][2];
#pragma unroll
        for (int bj = 0; bj < 2; ++bj) { gg[bj][0] = *(const f32x4*)(gpost + col0 + bj * HALF); gg[bj][1] = *(const f32x4*)(gpost + col0 + bj * HALF + 4); }
#pragma unroll
        for (int ai = 0; ai < 2; ++ai) {
            u32x4 xw[4][2];
#pragma unroll
            for (int m = 0; m < 4; ++m)
#pragma unroll
                for (int bj = 0; bj < 2; ++bj) xw[m][bj] = *(const u32x4*)(X + (size_t)(row0 + ai * HALF + m * 16) * ND + col0 + bj * HALF);
#pragma unroll
            for (int m = 0; m < 4; ++m) { const int row = row0 + ai * HALF + m * 16; const float r1 = ry[ai][m];
                float t2 = 0.f;
#pragma unroll
                for (int bj = 0; bj < 2; ++bj) { bf16_t* xp = X + (size_t)row * ND + col0 + bj * HALF; const u32x4 x4 = xw[m][bj];
                    f32x4 v0 = acc[ai][bj][m][0] * r1 * gg[bj][0], v1 = acc[ai][bj][m][1] * r1 * gg[bj][1];
                    v0[0] += __uint_as_float(x4.x << 16); v0[1] += __uint_as_float(x4.x & 0xffff0000u); v0[2] += __uint_as_float(x4.y << 16); v0[3] += __uint_as_float(x4.y & 0xffff0000u);
                    v1[0] += __uint_as_float(x4.z << 16); v1[1] += __uint_as_float(x4.z & 0xffff0000u); v1[2] += __uint_as_float(x4.w << 16); v1[3] += __uint_as_float(x4.w & 0xffff0000u);
                    if (FINAL) { float* fo = fout + (size_t)row * ND + col0 + bj * HALF; *(f32x4*)fo = v0; *(f32x4*)(fo + 4) = v1; }
                    else { t2 += ((v0[0] * v0[0] + v0[1] * v0[1]) + (v0[2] * v0[2] + v0[3] * v0[3])) + ((v1[0] * v1[0] + v1[1] * v1[1]) + (v1[2] * v1[2] + v1[3] * v1[3]));
                        u32x4 w; w.x = cvt_pk_bf16(v0[0], v0[1]); w.y = cvt_pk_bf16(v0[2], v0[3]); w.z = cvt_pk_bf16(v1[0], v1[1]); w.w = cvt_pk_bf16(v1[2], v1[3]); *(u32x4*)xp = w; } }
                if (!FINAL) { t2 += __shfl_xor(t2, 16); t2 += __shfl_xor(t2, 32);
                    if (fq == 0) (void)__hip_atomic_fetch_add(SB + row, (unsigned long long)(t2 * FXS), __ATOMIC_RELAXED, __HIP_MEMORY_SCOPE_AGENT); } } }
    }
};

template <class Epi, class Sched, bool ALIGN_EPI = false, bool SP2 = false>
__device__ __forceinline__ void gemm_phase(PG8_LAS unsigned char* lds, const Gemm g, const Sched& S, const Epi& E, int tid) {
    asm volatile("" : "+v"(tid));
    const int wid = __builtin_amdgcn_readfirstlane(tid >> 6), lane = tid & 63, wr = wid >> 2, wc = wid & 3, fr = lane & 15, fq = lane >> 4;
    const int K = g.K, nt = K / BK;
    unsigned voffA[2], voffB[2];
#pragma unroll
    for (int i = 0; i < 2; ++i) { int R, C; stage_rc(tid * 16 + i * 8192, R, C); const int Rb = Epi::PERM ? ((R & ~31) + perm32(R & 31)) : R;
        voffA[i] = (unsigned)(R * K + C) * 2u; voffB[i] = (unsigned)(Rb * K + C) * 2u; }
    const size_t kstep = (size_t)(BK * 2);
    const size_t hstep = (size_t)HALF * K * 2;
    const size_t tstep = 2 * hstep;
    const unsigned ldsw = (unsigned)wid * 1024u;
    const int aoff = lds_byte(wr * 64 + fr, fq * 8), boff = lds_byte(wc * 32 + fr, fq * 8);
#define PG8_SA(b, h) (((b) * 2 + (h)) * HTB)
#define PG8_SB(b, h) ((4 + (b) * 2 + (h)) * HTB)
#define PG8_STAGE(bufoff, gbase, voff) do { _Pragma("unroll") for (int _i = 0; _i < 2; ++_i) \
        __builtin_amdgcn_global_load_lds((const unsigned*)((const char*)(gbase) + (voff)[_i]), (PG8_LAS unsigned*)(lds + (bufoff) + ldsw + _i * 8192), 16, 0, 0); } while (0)
#define PG8_LDA(dst, b, h) do { _Pragma("unroll") for (int m = 0; m < 4; ++m) _Pragma("unroll") for (int k = 0; k < 2; ++k) dst[m][k] = *(const PG8_LAS bf16x8*)(lds + PG8_SA(b, h) + aoff + m * 2048 + k * 1024); } while (0)
#define PG8_LDB(dst, b, h) do { _Pragma("unroll") for (int n = 0; n < 2; ++n) _Pragma("unroll") for (int k = 0; k < 2; ++k) dst[n][k] = *(const PG8_LAS bf16x8*)(lds + PG8_SB(b, h) + boff + n * 2048 + k * 1024); } while (0)
#define PG8_MMA(ai, bj, At, Bt) do { __builtin_amdgcn_s_setprio(1); _Pragma("unroll") for (int m = 0; m < 4; ++m) _Pragma("unroll") for (int n = 0; n < 2; ++n) _Pragma("unroll") for (int k = 0; k < 2; ++k) \
        acc[ai][bj][m][n] = __builtin_amdgcn_mfma_f32_16x16x32_bf16(Bt[n][k], At[m][k], acc[ai][bj][m][n], 0, 0, 0); __builtin_amdgcn_s_setprio(0); } while (0)
#define PG8_WAIT_V(n) asm volatile("s_waitcnt vmcnt(" #n ")" ::: "memory")
#define PG8_WAIT_L(n) asm volatile("s_waitcnt lgkmcnt(" #n ")" ::: "memory")
#define PG8_BAR __builtin_amdgcn_s_barrier()
#define PG8_SCHED __builtin_amdgcn_sched_barrier(0)
    Unit cur, nxt; int ui = 0;
    if (!S.next(0, cur)) return;
    f32x4 acc[2][2][4][2];
#pragma unroll
    for (int a = 0; a < 2; ++a)
#pragma unroll
        for (int b = 0; b < 2; ++b)
#pragma unroll
            for (int m = 0; m < 4; ++m)
#pragma unroll
                for (int n = 0; n < 2; ++n) acc[a][b][m][n] = (f32x4){0.f, 0.f, 0.f, 0.f};
    bf16x8 At[4][2], B0[2][2], B1[2][2];
    const char* cA = (const char*)g.A + (size_t)cur.pm * tstep; const char* cB = (const char*)g.Bt + (size_t)cur.pn * tstep;
    S.a_ready(cur);
    if constexpr (SP2) {
        PG8_STAGE(PG8_SB(0, 0), cB, voffB); PG8_STAGE(PG8_SB(0, 1), cB + hstep, voffB); PG8_STAGE(PG8_SA(0, 0), cA, voffA); PG8_STAGE(PG8_SA(0, 1), cA + hstep, voffA);
        if (wr == 1) PG8_BAR;
        PG8_WAIT_V(2); PG8_BAR;
        PG8_STAGE(PG8_SB(1, 0), cB + kstep, voffB); PG8_STAGE(PG8_SA(1, 0), cA + kstep, voffA); PG8_STAGE(PG8_SB(1, 1), cB + hstep + kstep, voffB);
        PG8_WAIT_V(6); PG8_BAR;
    } else {
        PG8_STAGE(PG8_SB(0, 0), cB, voffB); PG8_STAGE(PG8_SA(0, 0), cA, voffA); PG8_STAGE(PG8_SB(0, 1), cB + hstep, voffB); PG8_STAGE(PG8_SA(0, 1), cA + hstep, voffA);
        if (wr == 1) PG8_BAR;
        PG8_WAIT_V(4); PG8_BAR;
        PG8_STAGE(PG8_SB(1, 0), cB + kstep, voffB); PG8_STAGE(PG8_SA(1, 0), cA + kstep, voffA); PG8_STAGE(PG8_SB(1, 1), cB + hstep + kstep, voffB);
        PG8_WAIT_V(6); PG8_BAR;
    }
    for (;;) {
        const bool has_next = S.next(ui + 1, nxt);
        const char* nA = has_next ? (const char*)g.A + (size_t)nxt.pm * tstep : cA; const char* nB = has_next ? (const char*)g.Bt + (size_t)nxt.pn * tstep : cB;
        for (int t = 0; t < nt; t += 2) {
            const bool last = (t == nt - 2);
            const char* a1 = cA + (size_t)(t + 1) * kstep;
            const char* a2 = last ? nA : cA + (size_t)(t + 2) * kstep; const char* b2 = last ? nB : cB + (size_t)(t + 2) * kstep;
            const char* a3 = a2 + kstep; const char* b3 = b2 + kstep;
            if (last && has_next) S.a_ready(nxt);
            if constexpr (SP2) {
            PG8_LDB(B0, 0, 0); PG8_LDB(B1, 0, 1); PG8_SCHED; PG8_LDA(At, 0, 0); PG8_STAGE(PG8_SA(1, 1), a1 + hstep, voffA);
            PG8_WAIT_V(8); PG8_WAIT_L(0); PG8_BAR; PG8_MMA(0, 0, At, B0); PG8_MMA(0, 1, At, B1); PG8_BAR; PG8_SCHED;
            PG8_LDA(At, 0, 1); PG8_STAGE(PG8_SB(0, 0), b2, voffB); PG8_STAGE(PG8_SB(0, 1), b2 + hstep, voffB); PG8_STAGE(PG8_SA(0, 0), a2, voffA);
            PG8_WAIT_V(8); PG8_WAIT_L(0); PG8_BAR; PG8_MMA(1, 0, At, B0); PG8_MMA(1, 1, At, B1); PG8_BAR; PG8_SCHED;
            PG8_LDB(B0, 1, 0); PG8_LDB(B1, 1, 1); PG8_SCHED; PG8_LDA(At, 1, 0); PG8_STAGE(PG8_SA(0, 1), a2 + hstep, voffA);
            PG8_WAIT_V(8); PG8_WAIT_L(0); PG8_BAR; PG8_MMA(0, 0, At, B0); PG8_MMA(0, 1, At, B1); PG8_BAR; PG8_SCHED;
            PG8_LDA(At, 1, 1); PG8_STAGE(PG8_SB(1, 0), b3, voffB); PG8_STAGE(PG8_SB(1, 1), b3 + hstep, voffB); PG8_STAGE(PG8_SA(1, 0), a3, voffA);
            PG8_WAIT_V(8); PG8_WAIT_L(0); PG8_BAR; PG8_MMA(1, 0, At, B0); PG8_MMA(1, 1, At, B1); PG8_BAR; PG8_SCHED;
            } else {
            PG8_LDB(B0, 0, 0); PG8_SCHED; PG8_LDA(At, 0, 0); PG8_STAGE(PG8_SA(1, 1), a1 + hstep, voffA);
            PG8_WAIT_L(8); PG8_BAR; PG8_WAIT_L(0); PG8_MMA(0, 0, At, B0); PG8_BAR; PG8_SCHED;
            PG8_LDB(B1, 0, 1); PG8_STAGE(PG8_SB(0, 0), b2, voffB);
            PG8_BAR; PG8_WAIT_L(0); PG8_MMA(0, 1, At, B1); PG8_BAR;
            PG8_LDA(At, 0, 1); PG8_STAGE(PG8_SA(0, 0), a2, voffA);
            PG8_BAR; PG8_WAIT_L(0); PG8_MMA(1, 0, At, B0); PG8_BAR; PG8_SCHED;
            PG8_STAGE(PG8_SB(0, 1), b2 + hstep, voffB);
            PG8_WAIT_V(6); PG8_BAR; PG8_MMA(1, 1, At, B1); PG8_BAR;
            PG8_LDB(B0, 1, 0); PG8_SCHED; PG8_LDA(At, 1, 0); PG8_STAGE(PG8_SA(0, 1), a2 + hstep, voffA);
            PG8_WAIT_L(8); PG8_BAR; PG8_WAIT_L(0); PG8_MMA(0, 0, At, B0); PG8_BAR; PG8_SCHED;
            PG8_LDB(B1, 1, 1); PG8_STAGE(PG8_SB(1, 0), b3, voffB);
            PG8_BAR; PG8_WAIT_L(0); PG8_MMA(0, 1, At, B1); PG8_BAR;
            PG8_LDA(At, 1, 1); PG8_STAGE(PG8_SA(1, 0), a3, voffA);
            PG8_BAR; PG8_WAIT_L(0); PG8_MMA(1, 0, At, B0); PG8_BAR; PG8_SCHED;
            PG8_STAGE(PG8_SB(1, 1), b3 + hstep, voffB);
            PG8_WAIT_V(6); PG8_BAR; PG8_MMA(1, 1, At, B1); PG8_BAR;
            }
        }
        if constexpr (ALIGN_EPI) { if (wr == 0) PG8_BAR; }
        if constexpr (!Epi::AFTER_DRAIN) { E(acc, cur, wr, wc, fr, fq); S.done(cur); }
        if (!has_next) break;
#pragma unroll
        for (int a = 0; a < 2; ++a)
#pragma unroll
            for (int b = 0; b < 2; ++b)
#pragma unroll
                for (int m = 0; m < 4; ++m)
#pragma unroll
                    for (int n = 0; n < 2; ++n) acc[a][b][m][n] = (f32x4){0.f, 0.f, 0.f, 0.f};
        cur = nxt; cA = nA; cB = nB; ++ui;
        if constexpr (ALIGN_EPI) { if (wr == 1) PG8_BAR; }
    }
    PG8_WAIT_V(0);
    if constexpr (!ALIGN_EPI) { if (wr == 0) PG8_BAR; }
    PG8_BAR;
    if constexpr (Epi::AFTER_DRAIN) { E.fused(acc, cur, wr, wc, fr, fq, lds, wid, lane); S.done(cur); }
#undef PG8_SA
#undef PG8_SB
#undef PG8_STAGE
#undef PG8_LDA
#undef PG8_LDB
#undef PG8_MMA
#undef PG8_WAIT_V
#undef PG8_WAIT_L
#undef PG8_BAR
#undef PG8_SCHED
}
}


constexpr int NWAVES = 8, NTHR = 512;
constexpr int BATCH = 4, T = 8192, DM = 2048, DEPTH = 2, M = BATCH * T, HD = 64, DFF = 8192, PW = 5920;
constexpr int NQK = 4096, NV = 2048;
constexpr int C_QA = 0, C_KCA = 512, C_VCA = 640, C_KSA = 768, C_KWA = 896, C_QB = 1024, C_KB = 1536, C_QC = 2048, C_KC = 2560, C_QD = 3072, C_KD = 3584;
constexpr int R_VSA = 0, R_VWA = 128, R_VB = 256, R_VC = 768, R_VD = 1280, R_GA = 1792, R_FC = 1816;
constexpr float LOG2E = 1.4426950408889634f;
constexpr float QSCALE = 0.125f * LOG2E;
constexpr float EPS = 1e-6f;

constexpr size_t MiB = 1u << 20;
constexpr size_t WS_CTL = 0, CTL_ZERO_BYTES = 64 * 1024;
constexpr size_t WS_KC = 1 * MiB, WS_VC = 2 * MiB, WS_KMEAN = 3 * MiB, WS_CUM = 4 * MiB;
constexpr size_t WS_RSTD = 3 * MiB;
constexpr size_t WS_VCT = 5 * MiB, WS_KMH = 6 * MiB, WS_KML = 6 * MiB + 512 * 1024;
constexpr size_t WS_SW = 7 * MiB, SW_LAYER = 128 * 1024, SW_W2K = 0, SW_W2V = 32 * 1024, SW_HB = 64 * 1024;
constexpr size_t WS_W = 8 * MiB, W_LAYER = 98 * MiB;
constexpr size_t WO_QK = 0, WO_V = 16 * MiB, WO_OUT = 24 * MiB, WO_UP = 32 * MiB, WO_DOWN = 64 * MiB, WO_W1K = 96 * MiB, WO_W1V = 97 * MiB;
constexpr size_t WS_XN = 204 * MiB, WS_Y = 332 * MiB, WS_QK = 460 * MiB, WS_VT = 716 * MiB, WS_O = 844 * MiB, WS_H = 460 * MiB, WS_END = 972 * MiB;
constexpr size_t WS_VN = WS_Y;
constexpr size_t WS_NMSK = WS_END + 38 * MiB;
constexpr size_t WS_SEL = WS_VC, WS_PARTO = WS_Y, WS_PARTL = WS_END + 34 * MiB;
static_assert(true, "");
constexpr size_t WS_SSQ = WS_END + 32 * MiB;
constexpr size_t WS_VDF = WS_END;
constexpr int CW_BAR = 4096, CW_KMAX = 8192, CW_K2 = 8448, CW_Q = 9216, CW_NC = 10240;

constexpr int RING_BYTES = 131072, MISC_OFF = RING_BYTES + 320, LDS_BYTES = 147456;

#define GAS __attribute__((address_space(1)))
#define LAS __attribute__((address_space(3)))
typedef unsigned short bf16;
typedef unsigned v4u __attribute__((ext_vector_type(4)));
typedef unsigned v2u __attribute__((ext_vector_type(2)));
typedef float f32x4 __attribute__((ext_vector_type(4)));
#define LDS_WAIT() asm volatile("s_waitcnt lgkmcnt(0)" ::: "memory")
#define GM_WAIT() asm volatile("s_waitcnt vmcnt(0) lgkmcnt(0)" ::: "memory")
__device__ __forceinline__ unsigned f2bf(float f) { unsigned u = __builtin_bit_cast(unsigned, f); return (u + 0x7fffu + ((u >> 16) & 1u)) >> 16; }
__device__ __forceinline__ unsigned pk2(float lo, float hi) { return f2bf(lo) | (f2bf(hi) << 16); }
__device__ __forceinline__ float bf_lo(unsigned u) { return __uint_as_float(u << 16); }
__device__ __forceinline__ float bf_hi(unsigned u) { return __uint_as_float(u & 0xffff0000u); }
__device__ __forceinline__ float bf2f(bf16 h) { return __uint_as_float(((unsigned)h) << 16); }

#define XB_TMO      128
#define XB_XCNT(j)  (256  + 64 * (j))
#define XB_XSUB(j)  (1280 + 64 * (j))
#define XB_XGEN(j)  (2304 + 64 * (j))
#define XB_TOP      3328
#define XB_TOPGEN   3392
#define XCD_BAR_WORDS 3456
#define XB_SPIN_CAP (1u << 24)

__device__ __forceinline__ unsigned xb_ld(unsigned* p)              { return __hip_atomic_load(p, __ATOMIC_RELAXED, __HIP_MEMORY_SCOPE_AGENT); }
__device__ __forceinline__ unsigned xb_add(unsigned* p, unsigned v) { return __hip_atomic_fetch_add(p, v, __ATOMIC_RELAXED, __HIP_MEMORY_SCOPE_AGENT); }
__device__ __forceinline__ unsigned xb_xcc_id() { return (unsigned)__builtin_amdgcn_s_getreg((3 << 11) | 20) & 0xFu; }
#define XB_SPIN(cond, bar) do { unsigned _sp = 0; while (cond) { __builtin_amdgcn_s_sleep(1); \
    if ((++_sp & 255u) == 0u) { if (xb_ld(&(bar)[XB_TMO])) break; if (_sp > XB_SPIN_CAP) { atomicAdd(&(bar)[XB_TMO], 1u); break; } } } } while (0)

struct XcdBarrier {
    unsigned* bar; unsigned x; int lead;
    volatile LAS unsigned* st;
};

__device__ __forceinline__ XcdBarrier xcd_barrier_post(unsigned* bar, volatile LAS unsigned* st, int lead) {
    XcdBarrier b; b.bar = bar; b.x = xb_xcc_id(); b.st = st; b.lead = lead;
    if (lead) (void)xb_add(&bar[XB_XCNT(b.x)], 1u);
    return b;
}
__device__ __forceinline__ void xcd_barrier_complete(unsigned* bar, unsigned x, unsigned& nloc, unsigned& nx) {
    const unsigned G = gridDim.x * gridDim.y * gridDim.z;
    unsigned sum, cnt, mine, sp = 0u;
    for (;;) {
        sum = 0u; cnt = 0u; mine = 0u;
#pragma unroll
        for (unsigned j = 0; j < 16; ++j) { const unsigned c = xb_ld(&bar[XB_XCNT(j)]); sum += c; cnt += (c > 0u) ? 1u : 0u; mine = (j == x) ? c : mine; }
        if (sum == G) break;
        __builtin_amdgcn_s_sleep(1);
        if ((++sp & 255u) == 0u) { if (xb_ld(&bar[XB_TMO])) break; if (sp > XB_SPIN_CAP) { atomicAdd(&bar[XB_TMO], 1u); break; } }
    }
    nloc = mine > 0u ? mine : 1u; nx = cnt > 0u ? cnt : 1u;
}

__device__ __forceinline__ void xcd_barrier(const XcdBarrier& b) {
    asm volatile("s_waitcnt vmcnt(0)" ::: "memory");
    __syncthreads();
    if (b.lead) {
        unsigned* bar = b.bar;
        __builtin_amdgcn_s_waitcnt(0);
        unsigned nloc = b.st[0], nx = b.st[1];
        if (nloc == 0u) { xcd_barrier_complete(bar, b.x, nloc, nx); b.st[0] = nloc; b.st[1] = nx; }
        const unsigned old = xb_add(&bar[XB_XSUB(b.x)], 1u);
        const unsigned gen = old / nloc;
        if (old + 1u == (gen + 1u) * nloc) {
            __builtin_amdgcn_fence(__ATOMIC_RELEASE, "agent");
            asm volatile("s_waitcnt vmcnt(0)" ::: "memory");
            const unsigned og = xb_add(&bar[XB_TOP], 1u);
            const unsigned tg = og / nx;
            if (og + 1u == (tg + 1u) * nx) xb_add(&bar[XB_TOPGEN], 1u);
            else XB_SPIN(xb_ld(&bar[XB_TOPGEN]) == tg, bar);
            __builtin_amdgcn_fence(__ATOMIC_ACQUIRE, "agent");
            xb_add(&bar[XB_XGEN(b.x)], 1u);
            asm volatile("s_waitcnt vmcnt(0)" ::: "memory");
        } else {
            XB_SPIN(xb_ld(&bar[XB_XGEN(b.x)]) == gen, bar);
            __builtin_amdgcn_fence(__ATOMIC_ACQUIRE, "agent");
            asm volatile("s_waitcnt vmcnt(0)" ::: "memory");
        }
    }
    __syncthreads();
}


struct Args { const float* in[16]; float* out; unsigned char* ws; int ph_lo, ph_hi; };

__device__ __forceinline__ float wave_sum(float v) {
#pragma unroll
    for (int o = 1; o < 64; o <<= 1) v += __shfl_xor(v, o);
    return v;
}
__device__ __forceinline__ float wave_max(float v) {
#pragma unroll
    for (int o = 1; o < 64; o <<= 1) v = fmaxf(v, __shfl_xor(v, o));
    return v;
}
__device__ __forceinline__ unsigned long long wave_max_u64(unsigned long long v) {
#pragma unroll
    for (int o = 1; o < 64; o <<= 1) { unsigned lo = __shfl_xor((unsigned)v, o), hi = __shfl_xor((unsigned)(v >> 32), o); unsigned long long w = ((unsigned long long)hi << 32) | lo; v = w > v ? w : v; }
    return v;
}
__device__ __forceinline__ int t5_bucket(int d) {
    d = d < 0 ? 0 : d;
    if (d < 16) return d;
    const int b = 8 + (31 - __clz(d * d));
    return b < 31 ? b : 31;
}

__device__ __forceinline__ int map_qk(int r, float& sc) {
    sc = 1.f;
    if (r < 512) { sc = QSCALE; return r; }
    if (r < 640) return r;
    if (r < 768) return r;
    if (r < 896) return r;
    if (r < 1024) return 1024 + (r - 896);
    if (r < 1536) { sc = QSCALE; return 1304 + (r - 1024); }
    if (r < 2048) return 1816 + (r - 1536);
    if (r < 2560) { sc = QSCALE; return 2840 + (r - 2048); }
    if (r < 3072) return 3352 + (r - 2560);
    if (r < 3584) { sc = QSCALE; return 4384 + (r - 3072); }
    return 4896 + (r - 3584);
}
__device__ __forceinline__ int map_v(int r, float& sc) {
    sc = 1.f;
    if (r < 128) return 896 + r;
    if (r < 256) return 1152 + (r - 128);
    if (r < 768) return 2328 + (r - 256);
    if (r < 1280) return 3864 + (r - 768);
    if (r < 1792) return 5408 + (r - 1280);
    if (r < 1816) return 1280 + (r - 1792);
    if (r < 1824) return 4376 + (r - 1816);
    return -1;
}
template <int MODE, bool DEEP = false>
__device__ __forceinline__ void transpose_item(const float* W, int K, int N, bf16* WT, int ndst, LAS float* scr, int item, int lane, const float* gain = nullptr) {
    const int nblk = ndst / 32, kb = item / nblk, nb = item % nblk, k0 = 64 * kb, r0 = 32 * nb;
    float sc = 1.f; int src = r0 + (lane & 31);
    if (MODE == 1) src = map_qk(r0 + (lane & 31), sc);
    if (MODE == 2) src = map_v(r0 + (lane & 31), sc);
    if (DEEP) {
        float wv[32];
#pragma unroll
        for (int i = 0; i < 32; ++i) wv[i] = src >= 0 ? W[(size_t)(k0 + 2 * i + (lane >> 5)) * N + src] : 0.f;
#pragma unroll
        for (int i = 0; i < 32; ++i) { const int kk = 2 * i + (lane >> 5); const float gk = gain ? gain[k0 + kk] : 1.f; scr[kk * 33 + (lane & 31)] = wv[i] * (sc * gk); }
    } else {
#pragma unroll 8
    for (int i = 0; i < 32; ++i) { const int kk = 2 * i + (lane >> 5); const float gk = gain ? gain[k0 + kk] : 1.f; scr[kk * 33 + (lane & 31)] = src >= 0 ? W[(size_t)(k0 + kk) * N + src] * (sc * gk) : 0.f; }
    }
    LDS_WAIT(); asm volatile("" ::: "memory");
    const int c = lane & 7;
#pragma unroll
    for (int j = 0; j < 4; ++j) { const int n = (lane >> 3) + 8 * j; const LAS float* s = scr + (8 * c) * 33 + n;
        v4u o; o.x = pk2(s[0 * 33], s[1 * 33]); o.y = pk2(s[2 * 33], s[3 * 33]); o.z = pk2(s[4 * 33], s[5 * 33]); o.w = pk2(s[6 * 33], s[7 * 33]);
        *(GAS v4u*)(WT + (size_t)(r0 + n) * K + k0 + 8 * c) = o; }
    LDS_WAIT(); asm volatile("" ::: "memory");
}

__device__ __forceinline__ void norm_pre_row(const float* xrow, bf16* orow, float* rstd, int lane) {
    const f32x4* xr = (const f32x4*)xrow + lane;
    f32x4 v[8]; float s = 0.f;
#pragma unroll
    for (int j = 0; j < 8; ++j) { v[j] = xr[64 * j]; s += (v[j].x * v[j].x + v[j].y * v[j].y) + (v[j].z * v[j].z + v[j].w * v[j].w); }
    const float r = 1.f / sqrtf(wave_sum(s) * (1.f / DM) + EPS);
    if (lane == 0) *rstd = r;
    unsigned long long* o8 = (unsigned long long*)orow + lane;
#pragma unroll
    for (int j = 0; j < 8; ++j) o8[64 * j] = (unsigned long long)pk2(v[j].x, v[j].y) | ((unsigned long long)pk2(v[j].z, v[j].w) << 32);
}
__device__ __forceinline__ void norm_post_row(const bf16* yrow, bf16* xbrow, const float* g_post, float* fout, float* rstd, int lane) {
    const unsigned long long* y8 = (const unsigned long long*)yrow + lane; unsigned long long* x8 = (unsigned long long*)xbrow + lane;
    const f32x4* gp = (const f32x4*)g_post + lane;
    f32x4 y[8]; float s = 0.f;
#pragma unroll
    for (int j = 0; j < 8; ++j) { const unsigned long long w = y8[64 * j]; const unsigned a = (unsigned)w, b = (unsigned)(w >> 32);
        y[j].x = bf_lo(a); y[j].y = bf_hi(a); y[j].z = bf_lo(b); y[j].w = bf_hi(b);
        s += (y[j].x * y[j].x + y[j].y * y[j].y) + (y[j].z * y[j].z + y[j].w * y[j].w); }
    const float ry = 1.f / sqrtf(wave_sum(s) * (1.f / DM) + EPS);
    float s2 = 0.f;
#pragma unroll
    for (int j = 0; j < 8; ++j) { const unsigned long long w = x8[64 * j]; const unsigned a = (unsigned)w, b = (unsigned)(w >> 32); const f32x4 gg = gp[64 * j];
        y[j].x = bf_lo(a) + y[j].x * ry * gg.x; y[j].y = bf_hi(a) + y[j].y * ry * gg.y; y[j].z = bf_lo(b) + y[j].z * ry * gg.z; y[j].w = bf_hi(b) + y[j].w * ry * gg.w;
        s2 += (y[j].x * y[j].x + y[j].y * y[j].y) + (y[j].z * y[j].z + y[j].w * y[j].w); }
    if (fout) { f32x4* fo = (f32x4*)fout + lane;
#pragma unroll
        for (int j = 0; j < 8; ++j) fo[64 * j] = y[j]; }
    else { const float r2 = 1.f / sqrtf(wave_sum(s2) * (1.f / DM) + EPS); if (lane == 0) *rstd = r2;
#pragma unroll
        for (int j = 0; j < 8; ++j) x8[64 * j] = (unsigned long long)pk2(y[j].x, y[j].y) | ((unsigned long long)pk2(y[j].z, y[j].w) << 32); }
}

__device__ __forceinline__ void load_row64(const bf16* p, float (&v)[64]) {
    const uint4* q = (const uint4*)p;
#pragma unroll
    for (int i = 0; i < 8; ++i) { const uint4 w = q[i];
        v[8 * i + 0] = bf_lo(w.x); v[8 * i + 1] = bf_hi(w.x); v[8 * i + 2] = bf_lo(w.y); v[8 * i + 3] = bf_hi(w.y);
        v[8 * i + 4] = bf_lo(w.z); v[8 * i + 5] = bf_hi(w.z); v[8 * i + 6] = bf_lo(w.w); v[8 * i + 7] = bf_hi(w.w); }
}
__device__ __forceinline__ float dot_row64(const bf16* p, const float (&q)[64]) {
    const uint4* r = (const uint4*)p; float s0 = 0.f, s1 = 0.f;
#pragma unroll
    for (int i = 0; i < 8; ++i) { const uint4 w = r[i];
        s0 += bf_lo(w.x) * q[8 * i + 0]; s1 += bf_hi(w.x) * q[8 * i + 1]; s0 += bf_lo(w.y) * q[8 * i + 2]; s1 += bf_hi(w.y) * q[8 * i + 3];
        s0 += bf_lo(w.z) * q[8 * i + 4]; s1 += bf_hi(w.z) * q[8 * i + 5]; s0 += bf_lo(w.w) * q[8 * i + 6]; s1 += bf_hi(w.w) * q[8 * i + 7]; }
    return s0 + s1;
}
template <class F, class P>
__device__ __forceinline__ float naive_attend(const float (&q)[64], const bf16* Kb, size_t kpitch, const bf16* Vb, size_t vpitch, int nkeys, F f, P pstore, float& l_out, int lane) {
    float m = -INFINITY;
#pragma unroll 1
    for (int j = lane; j < nkeys; j += 64) { int row; float bias; if (f(j, row, bias)) { const float s = dot_row64(Kb + (size_t)row * kpitch, q) + bias; m = fmaxf(m, s); } }
    m = wave_max(m);
    float o[64]; float l = 0.f;
#pragma unroll
    for (int d = 0; d < 64; ++d) o[d] = 0.f;
#pragma unroll 1
    for (int j = lane; j < nkeys; j += 64) { int row; float bias; float p = 0.f;
        if (f(j, row, bias)) { const float s = dot_row64(Kb + (size_t)row * kpitch, q) + bias; p = exp2f(s - m); l += p;
            const uint4* r = (const uint4*)(Vb + (size_t)row * vpitch);
#pragma unroll
            for (int i = 0; i < 8; ++i) { const uint4 w = r[i];
                o[8 * i + 0] += p * bf_lo(w.x); o[8 * i + 1] += p * bf_hi(w.x); o[8 * i + 2] += p * bf_lo(w.y); o[8 * i + 3] += p * bf_hi(w.y);
                o[8 * i + 4] += p * bf_lo(w.z); o[8 * i + 5] += p * bf_hi(w.z); o[8 * i + 6] += p * bf_lo(w.w); o[8 * i + 7] += p * bf_hi(w.w); } }
        if (pstore) pstore[j] = p; }
    l = wave_sum(l);
    float res = 0.f;
#pragma unroll
    for (int d = 0; d < 64; ++d) { const float v = wave_sum(o[d]); if (lane == d) res = v; }
    l_out = l;
    return l > 0.f ? res / l : 0.f;
}
__device__ __forceinline__ float gelu_tanh(float x) { const float u = 0.7978845608028654f * (x + 0.044715f * x * x * x); return 0.5f * x * (1.f + tanhf(u)); }
__device__ __forceinline__ float log_sigmoid(float x) { return x >= 0.f ? -log1pf(expf(-x)) : x - log1pf(expf(x)); }
__device__ __forceinline__ float sigmoidf(float x) { return 1.f / (1.f + expf(-x)); }
__device__ __forceinline__ unsigned ord_f32(float f) { const unsigned u = __float_as_uint(f); return (u & 0x80000000u) ? ~u : (u | 0x80000000u); }


#ifdef NAIVE_ATT
#define NAIVE_PROLOG \
    const int tid = threadIdx.x, lane = tid & 63, wave = tid >> 6; \
    const int gw = blockIdx.x * 4 + wave, NGW = gridDim.x * 4; \
    unsigned char* ws = args.ws; \
    bf16* QK = (bf16*)(ws + WS_QK); bf16* VT = (bf16*)(ws + WS_VT); bf16* OB = (bf16*)(ws + WS_O); bf16* VN = (bf16*)(ws + WS_VN); \
    bf16* KCb = (bf16*)(ws + WS_KC); bf16* VCb = (bf16*)(ws + WS_VC); float* KMEAN = (float*)(ws + WS_KMEAN); float* CUM = (float*)(ws + WS_CUM); \
    const float* relb = args.in[15]; (void)QK; (void)VT; (void)OB; (void)VN; (void)KCb; (void)VCb; (void)KMEAN; (void)CUM; (void)relb; (void)lane; (void)gw; (void)NGW;

__global__ void __launch_bounds__(256) k_naive_vn(Args args) {
    __shared__ unsigned short tile[64][66];
    const bf16* VT = (const bf16*)(args.ws + WS_VT); bf16* VN = (bf16*)(args.ws + WS_VN);
    const int tx = threadIdx.x & 63, ty = threadIdx.x >> 6;
    for (int blk = blockIdx.x; blk < (NV / 64) * (M / 64); blk += gridDim.x) { const int cb = blk % (NV / 64), tb = blk / (NV / 64);
        for (int i = ty; i < 64; i += 4) tile[i][tx] = VT[(size_t)(cb * 64 + i) * M + tb * 64 + tx];
        __syncthreads();
        for (int i = ty; i < 64; i += 4) VN[(size_t)(tb * 64 + i) * NV + cb * 64 + tx] = tile[tx][i];
        __syncthreads(); }
}
__global__ void __launch_bounds__(256) k_naive_pre(Args args, int l) {
    __shared__ __attribute__((aligned(16))) unsigned char lds_raw[4 * 12288];
    LAS unsigned char* L = (LAS unsigned char*)lds_raw;
    NAIVE_PROLOG
            {
                LAS float* blk = (LAS float*)(L + wave * 12288); LAS float* hid = blk + 2048;
                const float* pe = args.in[9] + (size_t)l * 32 * 64;
                for (int u = gw; u < 2 * 8 * 511; u += NGW) {
                    const int which = u / (8 * 511), r = u % (8 * 511), bg = r / 511, c = r % 511, b = bg >> 1, g = bg & 1;
                    const float* w1 = args.in[which ? 12 : 10] + (size_t)l * 2048 * 256; const float* w2 = args.in[which ? 13 : 11] + (size_t)l * 256 * 64;
                    const int col = (which ? C_VCA : C_KCA) + g * 64;
                    for (int k = lane; k < 2048; k += 64) { const int j = k >> 6, d = k & 63; blk[k] = bf2f(QK[(size_t)(b * T + 16 * c + j) * NQK + col + d]) + pe[k]; }
                    LDS_WAIT();
                    float h0 = 0.f, h1 = 0.f, h2 = 0.f, h3 = 0.f;
                    for (int k = 0; k < 2048; ++k) { const float a = blk[k]; const float* wr = w1 + (size_t)k * 256 + lane; h0 += a * wr[0]; h1 += a * wr[64]; h2 += a * wr[128]; h3 += a * wr[192]; }
                    hid[lane] = gelu_tanh(h0); hid[lane + 64] = gelu_tanh(h1); hid[lane + 128] = gelu_tanh(h2); hid[lane + 192] = gelu_tanh(h3);
                    LDS_WAIT();
                    float o = 0.f;
                    for (int n = 0; n < 256; ++n) o += hid[n] * w2[n * 64 + lane];
                    (which ? VCb : KCb)[((size_t)bg * 512 + c) * 64 + lane] = (bf16)f2bf(o);
                    if (which) ((bf16*)(ws + WS_VCT))[((size_t)bg * 64 + lane) * 512 + c] = (bf16)f2bf(o);
                    LDS_WAIT();
                }
            }
            for (int u = gw; u < BATCH * 8 * 32; u += NGW) { const int bh = u >> 5, kb = u & 31, b = bh >> 3, h = bh & 7;
                float s = 0.f; const bf16* p = QK + (size_t)(b * T + kb * 256) * NQK + C_KB + h * 64 + lane;
                for (int i = 0; i < 256; ++i) s += bf2f(p[(size_t)i * NQK]);
                const float km = s * (1.f / 256.f); KMEAN[(size_t)u * 64 + lane] = km; const unsigned hb = f2bf(km); ((bf16*)(ws + WS_KMH))[(size_t)u * 64 + lane] = (bf16)hb; ((bf16*)(ws + WS_KML))[(size_t)u * 64 + lane] = (bf16)f2bf(km - bf_lo(hb)); }
            for (int u = gw; u < 16; u += NGW) { const int bg = u & 7; if (u < 8) KCb[((size_t)bg * 512 + 511) * 64 + lane] = 0; else ((bf16*)(ws + WS_VCT))[((size_t)bg * 64 + lane) * 512 + 511] = 0; }
            for (int u = gw; u < BATCH * 8; u += NGW) { const int b = u >> 3, h = u & 7; const float fb = args.in[14][l * 8 + h];
                const bf16* p = VT + (size_t)(R_FC + h) * M + (size_t)b * T + lane * 128; float s = 0.f;
                for (int i = 0; i < 128; ++i) s += log_sigmoid(bf2f(p[i]) + fb);
                float incl = s;
#pragma unroll
                for (int o = 1; o < 64; o <<= 1) { const float v = __shfl_up(incl, o); if (lane >= o) incl += v; }
                float run = incl - s; float* c = CUM + (size_t)u * T + lane * 128;
                for (int i = 0; i < 128; ++i) { run += log_sigmoid(bf2f(p[i]) + fb); c[i] = run * LOG2E; } }
}
template <int MIX> __global__ void __launch_bounds__(256, 1) k_naive_bcd(Args args, int l) {
    NAIVE_PROLOG
            for (int u = gw; u < BATCH * 8 * T; u += NGW) {
                constexpr int mix = MIX; const int r = u, bh = r / T, t = r % T, b = bh >> 3, h = bh & 7;
                const size_t tok = (size_t)b * T + t;
                float q[64]; float lsum; float res;
                if constexpr (mix == 0) {
                    load_row64(QK + tok * NQK + C_QC + h * 64, q);
                    const float* c = CUM + (size_t)bh * T;
                    res = naive_attend(q, QK + (size_t)b * T * NQK + C_KC + h * 64, NQK, VN + (size_t)b * T * NV + R_VC + h * 64, NV, t + 1,
                        [&](int j, int& row, float& bias) { row = j; bias = -c[j]; return true; }, (LAS float*)nullptr, lsum, lane);
                    OB[tok * DM + 1024 + h * 64 + lane] = (bf16)f2bf(res);
                } else if constexpr (mix == 1) {
                    load_row64(QK + tok * NQK + C_QD + h * 64, q);
                    res = naive_attend(q, QK + (size_t)b * T * NQK + C_KD + h * 64, NQK, VN + (size_t)b * T * NV + R_VD + h * 64, NV, 3 * 129,
                        [&](int j, int& row, float& bias) { const int pat = j / 129, i = j % 129, dil = pat == 0 ? 1 : (pat == 1 ? 4 : 16); const int pos = t - i * dil;
                            row = pos; bias = relb[t5_bucket(i * dil) * 24 + 16 + h] * LOG2E; return pos >= 0; }, (LAS float*)nullptr, lsum, lane);
                    OB[tok * DM + 1536 + h * 64 + lane] = (bf16)f2bf(res);
                } else {
                    load_row64(QK + tok * NQK + C_QB + h * 64, q);
                    const int cur = t >> 8;
                    unsigned long long key = 0ull;
                    if (lane < cur) { const float* km = KMEAN + ((size_t)bh * 32 + lane) * 64; float gsum = 0.f;
#pragma unroll
                        for (int d = 0; d < 64; ++d) gsum += q[d] * km[d];
                        key = ((unsigned long long)ord_f32(gsum) << 32) | (unsigned)(0xffffffffu - (unsigned)lane); }
                    int selb[3];
#pragma unroll
                    for (int rr = 0; rr < 3; ++rr) { const unsigned long long best = wave_max_u64(key);
                        selb[rr] = best ? (int)(0xffffffffu - (unsigned)(best & 0xffffffffull)) : -1; if (key == best) key = 0ull; }
                    res = naive_attend(q, QK + (size_t)b * T * NQK + C_KB + h * 64, NQK, VN + (size_t)b * T * NV + R_VB + h * 64, NV, 4 * 256,
                        [&](int j, int& row, float& bias) { const int seg = j >> 8; int blkk = seg == 0 ? selb[0] : (seg == 1 ? selb[1] : (seg == 2 ? selb[2] : cur));
                            if (blkk < 0) return false; const int pos = blkk * 256 + (j & 255); row = pos; bias = relb[t5_bucket(t - pos) * 24 + 8 + h] * LOG2E; return pos <= t; },
                        (LAS float*)nullptr, lsum, lane);
                    OB[tok * DM + 512 + h * 64 + lane] = (bf16)f2bf(res);
                }
            }
}
__global__ void __launch_bounds__(256, 1) k_naive_nsa(Args args, int l) {
    NAIVE_PROLOG
    float* wsf = (float*)(ws + WS_END) + (size_t)gw * 2048;
            for (int u = gw; u < BATCH * 2 * T; u += NGW) {
                const int bg = u / T, t = u % T, b = bg >> 1, g = bg & 1; const size_t tok = (size_t)b * T + t;
                float* tmp = wsf; float* pcs = wsf + 512; int* sel = (int*)(wsf + 1024);
                for (int c = lane; c < 512; c += 64) pcs[c] = 0.f;
                float* ocs = wsf + 1100;
                for (int r = 0; r < 4; ++r) { const int hd = g * 4 + r; float q[64]; load_row64(QK + tok * NQK + C_QA + hd * 64, q); float lsum;
                    ocs[r * 64 + lane] = naive_attend(q, KCb + (size_t)bg * 512 * 64, 64, VCb + (size_t)bg * 512 * 64, 64, 511,
                        [&](int j, int& row, float& bias) { row = j; const int dc = t - (16 * j + 31); bias = relb[t5_bucket(dc) * 24 + hd] * LOG2E; return dc >= 0; }, tmp, lsum, lane);
                    GM_WAIT();
                    if (lsum > 0.f) { const float inv = 1.f / lsum; for (int c = lane; c < 511; c += 64) pcs[c] += tmp[c] * inv; }
                    GM_WAIT(); }
                const int cur = t >> 6;
                unsigned long long key[2];
#pragma unroll
                for (int e = 0; e < 2; ++e) { const int n = lane + 64 * e; float imp = 0.f;
                    for (int c = 4 * n - 1; c <= 4 * n + 3; ++c) if (c >= 0 && c < 511) imp += pcs[c];
                    const bool forced = (n == 0) || (n == cur) || (n == cur - 1), valid = n <= cur;
                    const float v = forced ? 1e30f : (valid ? imp : -1e30f);
                    key[e] = valid ? (((unsigned long long)ord_f32(v) << 32) | (unsigned)(0xffffffffu - (unsigned)n)) : 0ull; }
                for (int rr = 0; rr < 16; ++rr) { const unsigned long long mine = key[0] > key[1] ? key[0] : key[1]; const unsigned long long best = wave_max_u64(mine);
                    if (lane == 0) sel[rr] = best ? (int)(0xffffffffu - (unsigned)(best & 0xffffffffull)) : -1;
                    if (key[0] == best) key[0] = 0ull; if (key[1] == best) key[1] = 0ull; }
                GM_WAIT();
                for (int r = 0; r < 4; ++r) { const int hd = g * 4 + r; float q[64]; load_row64(QK + tok * NQK + C_QA + hd * 64, q); float lsum;
                    const float os = naive_attend(q, QK + (size_t)b * T * NQK + C_KSA + g * 64, NQK, VN + (size_t)b * T * NV + R_VSA + g * 64, NV, 16 * 64,
                        [&](int j, int& row, float& bias) { const int blkk = sel[j >> 6]; if (blkk < 0) return false; const int pos = blkk * 64 + (j & 63); row = pos;
                            bias = relb[t5_bucket(t - pos) * 24 + hd] * LOG2E; return pos <= t; }, (float*)nullptr, lsum, lane);
                    const float ow = naive_attend(q, QK + (size_t)b * T * NQK + C_KWA + g * 64, NQK, VN + (size_t)b * T * NV + R_VWA + g * 64, NV, 512,
                        [&](int j, int& row, float& bias) { const int pos = t - j; row = pos; bias = relb[t5_bucket(j) * 24 + hd] * LOG2E; return pos >= 0; }, (float*)nullptr, lsum, lane);
                    const float g0 = sigmoidf(bf2f(VT[(size_t)(R_GA + 0 * 8 + hd) * M + tok])), g1 = sigmoidf(bf2f(VT[(size_t)(R_GA + 1 * 8 + hd) * M + tok])), g2 = sigmoidf(bf2f(VT[(size_t)(R_GA + 2 * 8 + hd) * M + tok]));
                    OB[tok * DM + hd * 64 + lane] = (bf16)f2bf(g0 * ocs[r * 64 + lane] + g1 * os + g2 * ow); }
                GM_WAIT();
            }
}
#endif


typedef short bf16x8 __attribute__((ext_vector_type(8)));
#define MFMA16(a, b, c) __builtin_amdgcn_mfma_f32_16x16x32_bf16((a), (b), (c), 0, 0, 0)
__device__ __forceinline__ bf16x8 ld16(const bf16* p) { return *(const bf16x8*)p; }
__device__ __forceinline__ float rg_max(float v) {
    v = fmaxf(v, __shfl_xor(v, 16));
    auto b = __builtin_amdgcn_permlane32_swap(__float_as_uint(v), __float_as_uint(v), false, false);
    return fmaxf(__uint_as_float(b[0]), __uint_as_float(b[1]));
}
__device__ __forceinline__ float rg_sum(float v) {
    v += __shfl_xor(v, 16);
    auto b = __builtin_amdgcn_permlane32_swap(__float_as_uint(v), __float_as_uint(v), false, false);
    return __uint_as_float(b[0]) + __uint_as_float(b[1]);
}
__device__ __forceinline__ unsigned rg_max_u32(unsigned v) {
    const unsigned w = __shfl_xor(v, 16); v = w > v ? w : v;
    auto b = __builtin_amdgcn_permlane32_swap(v, v, false, false);
    return b[0] > b[1] ? b[0] : b[1];
}
__device__ __forceinline__ unsigned cvt_pk(float lo, float hi) { return pg8::cvt_pk_bf16(lo, hi); }
typedef unsigned u32x4t __attribute__((ext_vector_type(4)));

struct AttSt { f32x4 ot[4]; f32x4 lv; float m, l; };
__device__ __forceinline__ void att_init(AttSt& s) {
#pragma unroll
    for (int i = 0; i < 4; ++i) s.ot[i] = (f32x4){0.f, 0.f, 0.f, 0.f};
    s.lv = (f32x4){0.f, 0.f, 0.f, 0.f}; s.m = -INFINITY; s.l = 0.f;
}
__device__ __forceinline__ bf16x8 att_softmax(AttSt& st, f32x4 a0, f32x4 a1) {
    float mx = fmaxf(fmaxf(fmaxf(a0[0], a0[1]), fmaxf(a0[2], a0[3])), fmaxf(fmaxf(a1[0], a1[1]), fmaxf(a1[2], a1[3])));
    mx = rg_max(mx);
    const float mnew = fmaxf(st.m, mx);
    const float ms = (mnew == -INFINITY) ? 0.f : mnew;
    const float alpha = __builtin_amdgcn_exp2f(st.m - ms);
    st.m = mnew;
    float p[8];
#pragma unroll
    for (int i = 0; i < 4; ++i) { p[i] = __builtin_amdgcn_exp2f(a0[i] - ms); p[4 + i] = __builtin_amdgcn_exp2f(a1[i] - ms); }
    st.l = st.l * alpha + (((p[0] + p[1]) + (p[2] + p[3])) + ((p[4] + p[5]) + (p[6] + p[7])));
#pragma unroll
    for (int i = 0; i < 4; ++i) st.ot[i] = st.ot[i] * alpha;
    u32x4t w; w.x = cvt_pk(p[0], p[1]); w.y = cvt_pk(p[2], p[3]); w.z = cvt_pk(p[4], p[5]); w.w = cvt_pk(p[6], p[7]);
    return __builtin_bit_cast(bf16x8, w);
}
__device__ __forceinline__ bf16x8 att_softmax_ref(AttSt& st, f32x4 a0, f32x4 a1) {
    float p[8];
#pragma unroll
    for (int i = 0; i < 4; ++i) { p[i] = __builtin_amdgcn_exp2f(a0[i]); p[4 + i] = __builtin_amdgcn_exp2f(a1[i]); }
    st.l += (((p[0] + p[1]) + (p[2] + p[3])) + ((p[4] + p[5]) + (p[6] + p[7])));
    u32x4t w; w.x = cvt_pk(p[0], p[1]); w.y = cvt_pk(p[2], p[3]); w.z = cvt_pk(p[4], p[5]); w.w = cvt_pk(p[6], p[7]);
    return __builtin_bit_cast(bf16x8, w);
}
__device__ __forceinline__ float q_norm(const bf16x8 (&q)[2]) {
    float s = 0.f;
#pragma unroll
    for (int k = 0; k < 2; ++k) { const u32x4t w = __builtin_bit_cast(u32x4t, q[k]);
        s += bf_lo(w.x) * bf_lo(w.x) + bf_hi(w.x) * bf_hi(w.x) + bf_lo(w.y) * bf_lo(w.y) + bf_hi(w.y) * bf_hi(w.y) + bf_lo(w.z) * bf_lo(w.z) + bf_hi(w.z) * bf_hi(w.z) + bf_lo(w.w) * bf_lo(w.w) + bf_hi(w.w) * bf_hi(w.w); }
    return sqrtf(rg_sum(s));
}
__device__ __forceinline__ void att_finish(AttSt& st, float gate) {
    const float lt = rg_sum(st.l);
    const float sc = lt > 0.f ? gate / lt : 0.f;
#pragma unroll
    for (int i = 0; i < 4; ++i) st.ot[i] = st.ot[i] * sc;
}
struct KVFrag { bf16x8 k[2][2]; bf16x8 v[4]; };
__device__ __forceinline__ void kv_load(KVFrag& f, const bf16* Kb, size_t kpitch, const bf16* Vb, size_t vpitch, int k0, int n, int rg) {
    const bf16* kr = Kb + (size_t)(k0 + 8 * (n >> 2) + (n & 3)) * kpitch + 8 * rg;
#pragma unroll
    for (int e = 0; e < 2; ++e)
#pragma unroll
        for (int s = 0; s < 2; ++s) f.k[e][s] = ld16(kr + (size_t)(4 * e) * kpitch + 32 * s);
    const bf16* vr = Vb + (size_t)n * vpitch + k0 + 8 * rg;
#pragma unroll
    for (int dt = 0; dt < 4; ++dt) f.v[dt] = ld16(vr + (size_t)(16 * dt) * vpitch);
}
__device__ __forceinline__ void att_qk(f32x4 (&acc)[2], const KVFrag& f, const bf16x8 (&q)[2], f32x4 i0, f32x4 i1) {
    acc[0] = MFMA16(f.k[0][0], q[0], i0); acc[1] = MFMA16(f.k[1][0], q[0], i1);
    acc[0] = MFMA16(f.k[0][1], q[1], acc[0]); acc[1] = MFMA16(f.k[1][1], q[1], acc[1]);
}
__device__ __forceinline__ void att_pv(AttSt& st, const KVFrag& f, bf16x8 p) {
#pragma unroll
    for (int dt = 0; dt < 4; ++dt) st.ot[dt] = MFMA16(f.v[dt], p, st.ot[dt]);
}
__device__ __forceinline__ bf16x8 att_softmax_refm(f32x4 a0, f32x4 a1) {
    float p[8];
#pragma unroll
    for (int i = 0; i < 4; ++i) { p[i] = __builtin_amdgcn_exp2f(a0[i]); p[4 + i] = __builtin_amdgcn_exp2f(a1[i]); }
    u32x4t w; w.x = cvt_pk(p[0], p[1]); w.y = cvt_pk(p[2], p[3]); w.z = cvt_pk(p[4], p[5]); w.w = cvt_pk(p[6], p[7]);
    return __builtin_bit_cast(bf16x8, w);
}
__device__ __forceinline__ void att_pv_l(AttSt& st, const KVFrag& f, bf16x8 p) {
    const u32x4t o4 = {0x3F803F80u, 0x3F803F80u, 0x3F803F80u, 0x3F803F80u};
#pragma unroll
    for (int dt = 0; dt < 4; ++dt) st.ot[dt] = MFMA16(f.v[dt], p, st.ot[dt]);
    st.lv = MFMA16(__builtin_bit_cast(bf16x8, o4), p, st.lv);
}
__device__ __forceinline__ void att_finish_l(AttSt& st, float gate) {
    const float lt = st.lv[0];
    const float sc = lt > 0.f ? gate / lt : 0.f;
#pragma unroll
    for (int i = 0; i < 4; ++i) st.ot[i] = st.ot[i] * sc;
}
__device__ __forceinline__ int t5b(int d) { if (d < 16) return d < 0 ? 0 : d; const int b = 8 + (31 - __clz(d * d)); return b < 31 ? b : 31; }

template <int MIX>
__device__ __forceinline__ void att_dense_unit(int b, int h, int qb, int lane, const bf16* QK, const bf16* VT, const float* CUM, const bf16* KMH, const bf16* KML, bf16* OB, const LAS float* tabs, const unsigned* KMX) {
    asm volatile("" : "+v"(lane));
    const int n = lane & 15, rg = lane >> 4, q0 = qb * 32;
    constexpr int CQ = MIX == 0 ? C_QC : (MIX == 1 ? C_QD : C_QB), CK = MIX == 0 ? C_KC : (MIX == 1 ? C_KD : C_KB), RV = MIX == 0 ? R_VC : (MIX == 1 ? R_VD : R_VB);
    constexpr int OC = MIX == 0 ? 1024 : (MIX == 1 ? 1536 : 512), TH = MIX == 1 ? 16 : 8;
    const LAS float* tab = tabs + (TH + h) * 32;
    const bf16* Kb = QK + (size_t)b * T * NQK + CK + h * 64; const bf16* Vb = VT + (size_t)(RV + h * 64) * M + (size_t)b * T;
    const float* cum = CUM + (size_t)(b * 8 + h) * T;
    bf16x8 qf[2][2];
#pragma unroll
    for (int ct = 0; ct < 2; ++ct)
#pragma unroll
        for (int s = 0; s < 2; ++s) qf[ct][s] = ld16(QK + (size_t)(b * T + q0 + 16 * ct + n) * NQK + CQ + h * 64 + 32 * s + 8 * rg);
    const int qpos0 = q0 + n, qpos1 = q0 + 16 + n;
    AttSt st[2]; att_init(st[0]); att_init(st[1]);
    const float kmx = sqrtf(__uint_as_float(KMX[b * 28 + (MIX == 0 ? 8 : (MIX == 1 ? 16 : 0)) + h])) * 1.0001f;
    float nref[2], cq[2];
#pragma unroll
    for (int ct = 0; ct < 2; ++ct) { nref[ct] = -(q_norm(qf[ct]) * kmx + (MIX == 0 ? 0.f : tabs[768 + TH + h]) + (MIX == 1 ? 1.585f : 0.f)); cq[ct] = MIX == 0 ? cum[q0 + 16 * ct + n] : 0.f; }
    unsigned selm[2] = {0u, 0u}; unsigned wmask = 0u;
    const int own = qb >> 3;
    if (MIX == 2) {
        const bf16* kh = KMH + (size_t)(b * 8 + h) * 32 * 64; const bf16* kl = KML + (size_t)(b * 8 + h) * 32 * 64;
        bf16x8 gh[2][2], gl[2][2];
        const size_t ro = (size_t)(8 * (n >> 2) + (n & 3)) * 64 + 8 * rg;
#pragma unroll
        for (int e = 0; e < 2; ++e)
#pragma unroll
            for (int s = 0; s < 2; ++s) { gh[e][s] = ld16(kh + ro + (size_t)(4 * e) * 64 + 32 * s); gl[e][s] = ld16(kl + ro + (size_t)(4 * e) * 64 + 32 * s); }
#pragma unroll
        for (int ct = 0; ct < 2; ++ct) {
            f32x4 a0 = {0.f, 0.f, 0.f, 0.f}, a1 = {0.f, 0.f, 0.f, 0.f};
#pragma unroll
            for (int s = 0; s < 2; ++s) { a0 = MFMA16(gh[0][s], qf[ct][s], a0); a1 = MFMA16(gh[1][s], qf[ct][s], a1); a0 = MFMA16(gl[0][s], qf[ct][s], a0); a1 = MFMA16(gl[1][s], qf[ct][s], a1); }
            unsigned key[8];
#pragma unroll
            for (int i = 0; i < 8; ++i) { const int kb = 8 * rg + i; const float g = i < 4 ? a0[i] : a1[i - 4]; key[i] = kb < own ? ((ord_f32(g) & ~31u) | (unsigned)(31 - kb)) : 0u; }
#pragma unroll
            for (int r = 0; r < 3; ++r) { unsigned mx = key[0];
#pragma unroll
                for (int i = 1; i < 8; ++i) mx = key[i] > mx ? key[i] : mx;
                mx = rg_max_u32(mx);
                if (mx) selm[ct] |= 1u << (31 - (mx & 31u));
#pragma unroll
                for (int i = 0; i < 8; ++i) key[i] = key[i] == mx ? 0u : key[i]; }
        }
        unsigned um = selm[0] | selm[1];
#pragma unroll
        for (int o = 1; o < 64; o <<= 1) um |= __shfl_xor(um, o);
        wmask = um | (1u << own);
    }
    int ht, ht_last;
    if (MIX == 0) { ht = 0; ht_last = qb; } else if (MIX == 1) { ht = qb - 64 < 0 ? 0 : qb - 64; ht_last = qb; } else { ht = 8 * (__ffs(wmask) - 1); ht_last = qb; }
    auto next_ht = [&](int c) -> int {
        if (c >= ht_last) return -1;
        if (MIX != 2) return c + 1;
        if ((c & 7) != 7) return c + 1;
        const unsigned rem = wmask >> ((c >> 3) + 1); if (!rem) return -1;
        return 8 * ((c >> 3) + 1 + (__ffs(rem) - 1)); };
    auto step = [&](const KVFrag& f, f32x4 c0, f32x4 c1, int hc) {
        const int k0 = 32 * hc + 8 * rg;
#pragma unroll
        for (int ct = 0; ct < 2; ++ct) {
            const float base = nref[ct] + cq[ct];
            const f32x4 i0 = MIX == 0 ? (f32x4){base, base, base, base} - c0 : (f32x4){base, base, base, base}, i1 = MIX == 0 ? (f32x4){base, base, base, base} - c1 : i0;
            f32x4 acc[2]; att_qk(acc, f, qf[ct], i0, i1);
            const int qp = ct ? qpos1 : qpos0;
            if (MIX == 0) {
                if (hc == qb) {
#pragma unroll
                    for (int i = 0; i < 4; ++i) { if (k0 + i > qp) acc[0][i] = -INFINITY; if (k0 + 4 + i > qp) acc[1][i] = -INFINITY; } }
            } else if (MIX == 1) {
#pragma unroll
                for (int i = 0; i < 8; ++i) { const int d = qp - (k0 + i);
                    const int c1n = d <= 128 ? 1 : 0, c2n = ((d & 3) == 0 && d <= 512) ? 1 : 0, c3n = ((d & 15) == 0 && d <= 2048) ? 1 : 0; const int mult = c1n + c2n + c3n;
                    const float add = (d >= 0 && mult > 0) ? tab[t5b(d)] + (mult == 1 ? 0.f : (mult == 2 ? 1.f : 1.5849625007211562f)) : -INFINITY;
                    if (i < 4) acc[0][i] += add; else acc[1][i - 4] += add; }
            } else {
                const bool allowed = ((hc >> 3) == own) || ((selm[ct] >> (hc >> 3)) & 1u);
#pragma unroll
                for (int i = 0; i < 8; ++i) { const int d = qp - (k0 + i); const float add = (allowed && d >= 0) ? tab[t5b(d)] : -INFINITY;
                    if (i < 4) acc[0][i] += add; else acc[1][i - 4] += add; }
            }
            const bf16x8 p = att_softmax_ref(st[ct], acc[0], acc[1]);
            att_pv(st[ct], f, p);
        } };
    auto cinit = [&](f32x4& c0, f32x4& c1, int hc) {
        if (MIX == 0) { c0 = *(const f32x4*)(cum + 32 * hc + 8 * rg); c1 = *(const f32x4*)(cum + 32 * hc + 8 * rg + 4); }
        else { c0 = (f32x4){0.f, 0.f, 0.f, 0.f}; c1 = c0; } };
    KVFrag fa, fb; f32x4 ca0, ca1, cb0, cb1;
    cinit(ca0, ca1, ht); kv_load(fa, Kb, NQK, Vb, M, 32 * ht, n, rg);
    for (;;) {
        int nx = next_ht(ht); { const int pf = nx < 0 ? ht : nx; cinit(cb0, cb1, pf); kv_load(fb, Kb, NQK, Vb, M, 32 * pf, n, rg); }
        step(fa, ca0, ca1, ht);
        if (nx < 0) break;
        ht = nx; nx = next_ht(ht); { const int pf = nx < 0 ? ht : nx; cinit(ca0, ca1, pf); kv_load(fa, Kb, NQK, Vb, M, 32 * pf, n, rg); }
        step(fb, cb0, cb1, ht);
        if (nx < 0) break;
        ht = nx;
    }
#pragma unroll
    for (int ct = 0; ct < 2; ++ct) { att_finish(st[ct], 1.f);
        bf16* orow = OB + (size_t)(b * T + q0 + 16 * ct + n) * DM + OC + h * 64 + 4 * rg;
#pragma unroll
        for (int dt = 0; dt < 4; ++dt) { v2u w; w.x = cvt_pk(st[ct].ot[dt][0], st[ct].ot[dt][1]); w.y = cvt_pk(st[ct].ot[dt][2], st[ct].ot[dt][3]); *(v2u*)(orow + 16 * dt) = w; } }
}


constexpr int COOP_BUF = 8192, COOP_OFF = 8192, COOP_MASK_OFF = 4096, COOP_LUT_OFF = 24576, COOP_LUT_PAD = 288, COOP_LUT_N = 3296;
template <int MIX>
__device__ __forceinline__ void att_coop_unit(LAS unsigned char* L, int b, int h, int u256, int tid, const bf16* QK, const bf16* VT, const float* CUM, const bf16* KMH, const bf16* KML, bf16* OB, const LAS float* tabs, const unsigned* KMX, const bf16* VDF = nullptr, const bf16* PARTO = nullptr, const float* PARTL = nullptr) {
    asm volatile("" : "+v"(tid));
    const int lane = tid & 63, wave = __builtin_amdgcn_readfirstlane(tid >> 6), n = lane & 15, rg = lane >> 4, qb = 8 * u256 + wave, q0 = qb * 32;
    constexpr int CQ = MIX == 0 ? C_QC : (MIX == 1 ? C_QD : C_QB), CK = MIX == 0 ? C_KC : (MIX == 1 ? C_KD : C_KB), RV = MIX == 0 ? R_VC : (MIX == 1 ? R_VD : R_VB);
    constexpr int OC = MIX == 0 ? 1024 : (MIX == 1 ? 1536 : 512), TH = MIX == 1 ? 16 : 8;
    const LAS float* tab = tabs + (TH + h) * 32;
    const char* Kb = (const char*)(QK + (size_t)b * T * NQK + CK + h * 64); const char* Vb = (const char*)(VT + (size_t)(RV + h * 64) * M + (size_t)b * T);
    const float* cum = CUM + (size_t)(b * 8 + h) * T;
    bf16x8 qf[2][2];
#pragma unroll
    for (int ct = 0; ct < 2; ++ct)
#pragma unroll
        for (int s = 0; s < 2; ++s) qf[ct][s] = ld16(QK + (size_t)(b * T + (MIX == 1 ? 256 * u256 + 2 * wave + ct + 16 * n : q0 + 16 * ct + n)) * NQK + CQ + h * 64 + 32 * s + 8 * rg);
    const int qpos0 = MIX == 1 ? 256 * u256 + 2 * wave + 16 * n : q0 + n, qpos1 = MIX == 1 ? 256 * u256 + 2 * wave + 1 + 16 * n : q0 + 16 + n;
    AttSt st[2]; att_init(st[0]); att_init(st[1]);
    const float kmx = sqrtf(__uint_as_float(KMX[b * 28 + (MIX == 0 ? 8 : (MIX == 1 ? 16 : 0)) + h])) * 1.0001f;
    float nref[2], cq[2];
#pragma unroll
    for (int ct = 0; ct < 2; ++ct) { nref[ct] = -(q_norm(qf[ct]) * kmx + (MIX == 0 ? 0.f : tabs[768 + TH + h]) + (MIX == 1 ? 1.585f : 0.f)); cq[ct] = MIX == 0 ? cum[q0 + 16 * ct + n] : 0.f; }
    unsigned selm[2] = {0u, 0u}; unsigned wmask = 0u, umask = 0u;
    const int own = u256;
    LAS unsigned* mword = (LAS unsigned*)(L + COOP_MASK_OFF);
    if (MIX == 3) { wmask = 1u << own; umask = wmask; }
    if (MIX == 2) {
        const bf16* kh = KMH + (size_t)(b * 8 + h) * 32 * 64; const bf16* kl = KML + (size_t)(b * 8 + h) * 32 * 64;
        bf16x8 gh[2][2], gl[2][2];
        const size_t ro = (size_t)(8 * (n >> 2) + (n & 3)) * 64 + 8 * rg;
#pragma unroll
        for (int e = 0; e < 2; ++e)
#pragma unroll
            for (int s = 0; s < 2; ++s) { gh[e][s] = ld16(kh + ro + (size_t)(4 * e) * 64 + 32 * s); gl[e][s] = ld16(kl + ro + (size_t)(4 * e) * 64 + 32 * s); }
#pragma unroll
        for (int ct = 0; ct < 2; ++ct) {
            f32x4 a0 = {0.f, 0.f, 0.f, 0.f}, a1 = {0.f, 0.f, 0.f, 0.f};
#pragma unroll
            for (int s = 0; s < 2; ++s) { a0 = MFMA16(gh[0][s], qf[ct][s], a0); a1 = MFMA16(gh[1][s], qf[ct][s], a1); a0 = MFMA16(gl[0][s], qf[ct][s], a0); a1 = MFMA16(gl[1][s], qf[ct][s], a1); }
            unsigned key[8];
#pragma unroll
            for (int i = 0; i < 8; ++i) { const int kb = 8 * rg + i; const float g = i < 4 ? a0[i] : a1[i - 4]; key[i] = kb < own ? ((ord_f32(g) & ~31u) | (unsigned)(31 - kb)) : 0u; }
#pragma unroll
            for (int r = 0; r < 3; ++r) { unsigned mx = key[0];
#pragma unroll
                for (int i = 1; i < 8; ++i) mx = key[i] > mx ? key[i] : mx;
                mx = rg_max_u32(mx);
                if (mx) selm[ct] |= 1u << (31 - (mx & 31u));
#pragma unroll
                for (int i = 0; i < 8; ++i) key[i] = key[i] == mx ? 0u : key[i]; }
        }
        unsigned um = selm[0] | selm[1];
#pragma unroll
        for (int o = 1; o < 64; o <<= 1) um |= __shfl_xor(um, o);
        wmask = um | (1u << own);
        if (tid == 0) *mword = 0u;
        __syncthreads();
        if (lane == 0) __hip_atomic_fetch_or(mword, wmask, __ATOMIC_RELAXED, __HIP_MEMORY_SCOPE_WORKGROUP);
        __syncthreads();
        umask = *mword;
    }
    LAS float* lut = (LAS float*)(L + COOP_LUT_OFF);
    if (MIX != 0) {
        for (int i = tid; i < COOP_LUT_N; i += NTHR) { const int d = i - COOP_LUT_PAD; float v = -INFINITY;
            if (d >= 0) { if (MIX >= 2) v = tab[t5b(d)];
                else { const int mult = (d <= 128 ? 1 : 0) + (((d & 3) == 0 && d <= 512) ? 1 : 0) + (((d & 15) == 0 && d <= 512) ? 1 : 0); if (mult > 0) v = tab[t5b(d)] + (mult == 1 ? 0.f : (mult == 2 ? 1.f : 1.5849625007211562f)); } }
            lut[i] = v; }
    }
    const int ht_last = 8 * u256 + 7;
    int ht = MIX == 0 ? 0 : (MIX == 1 ? (8 * u256 - 16 < 0 ? 0 : 8 * u256 - 16) : 8 * (__ffs(umask) - 1));
    auto next_ht = [&](int c) -> int {
        if (c >= ht_last) return -1;
        if (MIX < 2) return c + 1;
        if ((c & 7) != 7) return c + 1;
        const unsigned rem = umask >> ((c >> 3) + 1); if (!rem) return -1;
        return 8 * ((c >> 3) + 1 + (__ffs(rem) - 1)); };
    const bool isk = tid < 256; const int t2 = tid & 255;
    const int lrow = isk ? (t2 >> 3) : (t2 >> 2), lch = isk ? (t2 & 7) : (t2 & 3);
    const size_t gofs = isk ? (size_t)lrow * (NQK * 2) + 16 * lch : (size_t)lrow * ((size_t)M * 2) + 16 * lch;
    const size_t gstep = isk ? (size_t)32 * NQK * 2 : (size_t)64;
    const char* gbase = (isk ? Kb : Vb) + gofs;
    const int lofs = isk ? 128 * lrow + 16 * (lch ^ (((lrow >> 4) & 1) * 5 + ((lrow >> 1) & 1) * 2)) : 4096 + 64 * lrow + 16 * (lch ^ (3 * ((lrow >> 3) & 1)));
    LAS unsigned char* tb = L + COOP_OFF;
    int kro[2][2], vro[4];
#pragma unroll
    for (int e = 0; e < 2; ++e) { const int rho = 8 * (n >> 2) + 4 * e + (n & 3); const int fk = ((rho >> 4) & 1) * 5 + ((rho >> 1) & 1) * 2;
#pragma unroll
        for (int s = 0; s < 2; ++s) kro[e][s] = 128 * rho + 16 * ((4 * s + rg) ^ fk); }
#pragma unroll
    for (int dt = 0; dt < 4; ++dt) { const int d = 16 * dt + n; vro[dt] = 4096 + 64 * d + 16 * (rg ^ (3 * ((d >> 3) & 1))); }
    auto step = [&](const LAS unsigned char* buf, f32x4 c0, f32x4 c1, int hc) {
        KVFrag f;
#pragma unroll
        for (int e = 0; e < 2; ++e)
#pragma unroll
            for (int s = 0; s < 2; ++s) f.k[e][s] = *(const LAS bf16x8*)(buf + kro[e][s]);
#pragma unroll
        for (int dt = 0; dt < 4; ++dt) f.v[dt] = *(const LAS bf16x8*)(buf + vro[dt]);
        const int k0 = 32 * hc + 8 * rg;
#pragma unroll
        for (int ct = 0; ct < 2; ++ct) {
            const float base = nref[ct] + cq[ct];
            const f32x4 i0 = MIX == 0 ? (f32x4){base, base, base, base} - c0 : (f32x4){base, base, base, base}, i1 = MIX == 0 ? (f32x4){base, base, base, base} - c1 : i0;
            f32x4 acc[2]; att_qk(acc, f, qf[ct], i0, i1);
            const int qp = ct ? qpos1 : qpos0;
            if (MIX == 0) {
                if (hc == qb) {
#pragma unroll
                    for (int i = 0; i < 4; ++i) { if (k0 + i > qp) acc[0][i] = -INFINITY; if (k0 + 4 + i > qp) acc[1][i] = -INFINITY; } }
            } else {
                const int dl = qp - k0;
                const int dlo_ = (q0 + 16 * ct) - (32 * hc + 31);
                if (MIX >= 2 && dlo_ >= 0 && t5b(dlo_) == t5b(dlo_ + 46)) {
                    const float add = (MIX == 3 || ((hc >> 3) == own) || ((selm[ct] >> (hc >> 3)) & 1u)) ? tab[t5b(dlo_)] : -INFINITY;
#pragma unroll
                    for (int i = 0; i < 4; ++i) { acc[0][i] += add; acc[1][i] += add; }
                } else {
                    const bool allowed = MIX == 1 || MIX == 3 || ((hc >> 3) == own) || ((selm[ct] >> (hc >> 3)) & 1u);
                    const LAS float* lp = lut + COOP_LUT_PAD + dl - 7;
                    float lv[8];
#pragma unroll
                    for (int i = 0; i < 8; ++i) lv[i] = lp[7 - i];
#pragma unroll
                    for (int i = 0; i < 8; ++i) { const float add = allowed ? lv[i] : -INFINITY; if (i < 4) acc[0][i] += add; else acc[1][i - 4] += add; }
                }
            }
            const bf16x8 p = att_softmax_refm(acc[0], acc[1]);
            att_pv_l(st[ct], f, p);
        } };
    auto need = [&](int hc) -> bool { if (MIX == 0) return hc <= qb; if (MIX == 1) return true; return ((hc >> 3) == own) ? hc <= qb : (MIX == 2 && ((wmask >> (hc >> 3)) & 1u) != 0u); };
    auto cinit = [&](f32x4& c0, f32x4& c1, int hc) {
        if (MIX == 0) { c0 = *(const f32x4*)(cum + 32 * hc + 8 * rg); c1 = *(const f32x4*)(cum + 32 * hc + 8 * rg + 4); }
        else { c0 = (f32x4){0.f, 0.f, 0.f, 0.f}; c1 = c0; } };
    f32x4 ca0, ca1, cb0, cb1;
    {   v4u r = *(const v4u*)(gbase + (size_t)ht * gstep); cinit(ca0, ca1, ht);
        *(LAS v4u*)(tb + lofs) = r; }
    __syncthreads();
    int par = 0;
    for (;;) {
        const int nx = next_ht(ht); const int pf = nx < 0 ? ht : nx;
        const v4u r = *(const v4u*)(gbase + (size_t)pf * gstep);
        if (par == 0) { cinit(cb0, cb1, pf); if (need(ht)) step(tb, ca0, ca1, ht); }
        else { cinit(ca0, ca1, pf); if (need(ht)) step(tb + COOP_BUF, cb0, cb1, ht); }
        *(LAS v4u*)(tb + (par ? 0 : COOP_BUF) + lofs) = r;
        __syncthreads();
        if (nx < 0) break;
        ht = nx; par ^= 1;
    }
    if (MIX == 1) {
        const int Qf = 16 * u256;
#pragma unroll
        for (int ct = 0; ct < 2; ++ct) { const int r = 2 * wave + ct;
            const bf16* Kr = QK + (size_t)(b * T + r) * NQK + CK + h * 64;
            const bf16* Vr = VDF + ((size_t)(b * 512 + h * 64) * 16 + r) * 512;
            const float base = nref[ct]; const f32x4 i0 = {base, base, base, base};
            for (int sft = 0; sft < 4; ++sft) { const int k0f = Qf - 128 + 32 * sft; if (k0f + 31 < 0) continue;
                KVFrag f;
                { const int kr0 = k0f + 8 * (n >> 2) + (n & 3);
#pragma unroll
                  for (int e = 0; e < 2; ++e) { const int kr = kr0 + 4 * e < 0 ? 0 : kr0 + 4 * e;
#pragma unroll
                      for (int s2 = 0; s2 < 2; ++s2) f.k[e][s2] = ld16(Kr + (size_t)(16 * kr) * NQK + 32 * s2 + 8 * rg); }
                  const int kc = k0f + 8 * rg < 0 ? 0 : k0f + 8 * rg;
#pragma unroll
                  for (int dt = 0; dt < 4; ++dt) f.v[dt] = ld16(Vr + (size_t)(16 * dt + n) * (16 * 512) + kc); }
                f32x4 acc[2]; att_qk(acc, f, qf[ct], i0, i0);
#pragma unroll
                for (int i = 0; i < 8; ++i) { const int kf = k0f + 8 * rg + i, di = (Qf + n) - kf;
                    const float add = (kf >= 0 && di >= 33 && di <= 128) ? tab[t5b(16 * di)] : -INFINITY; if (i < 4) acc[0][i] += add; else acc[1][i - 4] += add; }
                const bf16x8 p = att_softmax_refm(acc[0], acc[1]); att_pv_l(st[ct], f, p); } }
    }
    if (MIX == 3) {
        const int cnt = own < 3 ? own : 3;
#pragma unroll
        for (int ct = 0; ct < 2; ++ct) { const size_t pr = ((size_t)(b * 8 + h) * T + q0 + 16 * ct + n) * 3; float ladd = 0.f;
            float pl[3]; v2u pv[3][4];
#pragma unroll
            for (int sl = 0; sl < 3; ++sl) { const size_t ps = pr + (sl < cnt ? sl : 0); pl[sl] = PARTL[ps];
#pragma unroll
                for (int dt = 0; dt < 4; ++dt) pv[sl][dt] = *(const v2u*)(PARTO + ps * 64 + 16 * dt + 4 * rg); }
#pragma unroll
            for (int sl = 0; sl < 3; ++sl) if (sl < cnt) { ladd += pl[sl];
#pragma unroll
                for (int dt = 0; dt < 4; ++dt) st[ct].ot[dt] = st[ct].ot[dt] + (f32x4){bf_lo(pv[sl][dt].x), bf_hi(pv[sl][dt].x), bf_lo(pv[sl][dt].y), bf_hi(pv[sl][dt].y)}; }
            st[ct].lv[0] += ladd; }
    }
#pragma unroll
    for (int ct = 0; ct < 2; ++ct) { att_finish_l(st[ct], 1.f);
        bf16* orow = OB + (size_t)(b * T + (MIX == 1 ? 256 * u256 + 2 * wave + ct + 16 * n : q0 + 16 * ct + n)) * DM + OC + h * 64 + 4 * rg;
#pragma unroll
        for (int dt = 0; dt < 4; ++dt) { v2u w; w.x = cvt_pk(st[ct].ot[dt][0], st[ct].ot[dt][1]); w.y = cvt_pk(st[ct].ot[dt][2], st[ct].ot[dt][3]); *(v2u*)(orow + 16 * dt) = w; } }
}

constexpr int NSA_WLDS = 8 * 128 + 8 * 16 + 32 * 68;
__device__ __forceinline__ void att_nsa_unit(int b, int g, int t0, int lane, const bf16* QK, const bf16* VT, const bf16* KC, const bf16* VCT, bf16* OB, const LAS float* tabs, LAS float* wl, const unsigned* KMX) {
    asm volatile("" : "+v"(lane));
    const int n = lane & 15, rg = lane >> 4, bg = b * 2 + g, hd = 4 * g + (n & 3);
    LAS float* imp = wl; LAS int* sel = (LAS int*)(wl + 1024); LAS float* outl = wl + 1024 + 128;
    const LAS float* tab = tabs + hd * 32;
    int qpos[2]; float gate[3][2];
    auto load_q = [&](bf16x8 (&q)[2], int ct) {
#pragma unroll
        for (int s = 0; s < 2; ++s) q[s] = ld16(QK + (size_t)(b * T + t0 + 4 * ct + (n >> 2)) * NQK + C_QA + hd * 64 + 32 * s + 8 * rg); };
    float qn[2];
#pragma unroll
    for (int ct = 0; ct < 2; ++ct) { const int tk = t0 + 4 * ct + (n >> 2); qpos[ct] = tk; { bf16x8 qt[2]; load_q(qt, ct); qn[ct] = q_norm(qt); }
#pragma unroll
        for (int br = 0; br < 3; ++br) gate[br][ct] = sigmoidf(bf2f(VT[(size_t)(R_GA + br * 8 + hd) * M + (size_t)b * T + tk])); }
    const float tmx = tabs[768 + hd];
#pragma unroll
    for (int i = 0; i < 16; ++i) imp[lane + 64 * i] = 0.f;
    AttSt st[2]; att_init(st[0]); att_init(st[1]);
    const f32x4 z4 = {0.f, 0.f, 0.f, 0.f};
    const bf16* Kc = KC + (size_t)bg * 512 * 64; const bf16* Vc = VCT + (size_t)bg * 64 * 512;
    const int cmax = (t0 + 7 - 31) >> 4;
    auto cmp_fix = [&](f32x4 (&acc)[2], int k0, int qp) {
#pragma unroll
        for (int i = 0; i < 8; ++i) { const int dc = qp - 16 * (k0 + i) - 31; const float add = dc >= 0 ? tab[t5b(dc)] : -INFINITY; if (i < 4) acc[0][i] += add; else acc[1][i - 4] += add; } };
    if (cmax >= 0) {
        bf16x8 qf[2][2]; load_q(qf[0], 0); load_q(qf[1], 1);
        const int nh = (cmax >> 5) + 1;
        { auto cstep = [&](const KVFrag& f, int hc) {
#pragma unroll
                for (int ct = 0; ct < 2; ++ct) { f32x4 acc[2]; att_qk(acc, f, qf[ct], z4, z4); cmp_fix(acc, 32 * hc + 8 * rg, qpos[ct]); const bf16x8 p = att_softmax(st[ct], acc[0], acc[1]); att_pv(st[ct], f, p); } };
          KVFrag fa, fb; kv_load(fa, Kc, 64, Vc, 512, 0, n, rg);
          for (int hc = 0; hc < nh; hc += 2) { kv_load(fb, Kc, 64, Vc, 512, 32 * (hc + 1 < nh ? hc + 1 : hc), n, rg); cstep(fa, hc); if (hc + 1 >= nh) break;
              kv_load(fa, Kc, 64, Vc, 512, 32 * (hc + 2 < nh ? hc + 2 : hc + 1), n, rg); cstep(fb, hc + 1); } }
        float mfin[2], linv[2];
#pragma unroll
        for (int ct = 0; ct < 2; ++ct) { const float lt = rg_sum(st[ct].l); linv[ct] = lt > 0.f ? 1.f / lt : 0.f; mfin[ct] = st[ct].m == -INFINITY ? 0.f : st[ct].m; }
        LDS_WAIT();
        { auto istep = [&](const KVFrag& f, int hc) {
#pragma unroll
            for (int ct = 0; ct < 2; ++ct) { f32x4 acc[2]; att_qk(acc, f, qf[ct], z4, z4); cmp_fix(acc, 32 * hc + 8 * rg, qpos[ct]);
#pragma unroll
                for (int e = 0; e < 2; ++e) { float pe[4];
#pragma unroll
                    for (int i = 0; i < 4; ++i) pe[i] = exp2f(acc[e][i] - mfin[ct]) * linv[ct];
                    float G = (pe[0] + pe[1]) + (pe[2] + pe[3]), Lst = pe[3];
                    G += __shfl_xor(G, 1); G += __shfl_xor(G, 2); Lst += __shfl_xor(Lst, 1); Lst += __shfl_xor(Lst, 2);
                    if ((n & 3) == 0) { const int nb = 8 * hc + 2 * rg + e; LAS float* ip = imp + (4 * ct + (n >> 2)) * 128 + nb;
                        __hip_atomic_fetch_add(ip, G, __ATOMIC_RELAXED, __HIP_MEMORY_SCOPE_WORKGROUP); if (nb + 1 < 128) __hip_atomic_fetch_add(ip + 1, Lst, __ATOMIC_RELAXED, __HIP_MEMORY_SCOPE_WORKGROUP); } } }
            };
          KVFrag fa, fb; kv_load(fa, Kc, 64, Vc, 512, 0, n, rg);
          for (int hc = 0; hc < nh; hc += 2) { kv_load(fb, Kc, 64, Vc, 512, 32 * (hc + 1 < nh ? hc + 1 : hc), n, rg); istep(fa, hc); if (hc + 1 >= nh) break;
              kv_load(fa, Kc, 64, Vc, 512, 32 * (hc + 2 < nh ? hc + 2 : hc + 1), n, rg); istep(fb, hc + 1); } }
    }
#pragma unroll
    for (int ct = 0; ct < 2; ++ct) { att_finish(st[ct], gate[0][ct]);
#pragma unroll
        for (int dt = 0; dt < 4; ++dt) *(LAS f32x4*)(outl + (16 * ct + n) * 68 + 16 * dt + 4 * rg) = st[ct].ot[dt]; }
    LDS_WAIT();
    {
        const int tki = lane >> 3, sub = lane & 7, tk = t0 + tki, cur = tk >> 6;
        unsigned key[16];
#pragma unroll
        for (int k4 = 0; k4 < 4; ++k4) { const f32x4 v = *(const LAS f32x4*)(imp + tki * 128 + sub * 16 + 4 * k4);
#pragma unroll
            for (int i = 0; i < 4; ++i) { const int nb = sub * 16 + 4 * k4 + i; const bool forced = nb == 0 || nb == cur || nb == cur - 1;
                key[4 * k4 + i] = nb > cur ? 0u : (forced ? (0x7f000000u | (unsigned)(127 - nb)) : ((__float_as_uint(v[i]) & ~127u) | (unsigned)(127 - nb))); } }
        for (int r = 0; r < 16; ++r) { unsigned mx = key[0];
#pragma unroll
            for (int i = 1; i < 16; ++i) mx = key[i] > mx ? key[i] : mx;
            unsigned w;
            w = __shfl_xor(mx, 1); mx = w > mx ? w : mx; w = __shfl_xor(mx, 2); mx = w > mx ? w : mx; w = __shfl_xor(mx, 4); mx = w > mx ? w : mx;
            if (sub == 0) sel[tki * 16 + r] = mx ? (int)(127u - (mx & 127u)) : -1;
#pragma unroll
            for (int i = 0; i < 16; ++i) key[i] = key[i] == mx ? 0u : key[i]; }
    }
    LDS_WAIT();
    const bf16* Ks = QK + (size_t)b * T * NQK + C_KSA + g * 64; const bf16* Vs = VT + (size_t)(R_VSA + g * 64) * M + (size_t)b * T;
#pragma unroll 1
    for (int ct = 0; ct < 2; ++ct) {
        AttSt ss; att_init(ss);
        const int mytok = n >> 2;
        bf16x8 qc[2]; load_q(qc, ct); const int qpc = ct ? qpos[1] : qpos[0]; const float qnc = ct ? qn[1] : qn[0], g1c = ct ? gate[1][1] : gate[1][0];
        const float nrs = -(qnc * sqrtf(__uint_as_float(KMX[b * 28 + 24 + g])) * 1.0001f + tmx); const f32x4 zs = {nrs, nrs, nrs, nrs};
        bf16x8 kf[4][2][2], vf[4][4]; int blk[4], myblk;
        auto rd_sel = [&](int r) {
#pragma unroll
            for (int tq = 0; tq < 4; ++tq) blk[tq] = __builtin_amdgcn_readfirstlane(sel[(4 * ct + tq) * 16 + r]); };
        auto ldk = [&](int hh) {
#pragma unroll
            for (int tq = 0; tq < 4; ++tq) { const bf16* kr = Ks + (size_t)(64 * (blk[tq] < 0 ? 0 : blk[tq]) + 32 * hh + 8 * (n >> 2) + (n & 3)) * NQK + 8 * rg;
#pragma unroll
                for (int e = 0; e < 2; ++e)
#pragma unroll
                    for (int s2 = 0; s2 < 2; ++s2) kf[tq][e][s2] = ld16(kr + (size_t)(4 * e) * NQK + 32 * s2); } };
        auto ldv = [&](int hh) {
#pragma unroll
            for (int tq = 0; tq < 4; ++tq) { const bf16* vr = Vs + (size_t)n * M + 64 * (blk[tq] < 0 ? 0 : blk[tq]) + 32 * hh + 8 * rg;
#pragma unroll
                for (int dt = 0; dt < 4; ++dt) vf[tq][dt] = ld16(vr + (size_t)(16 * dt) * M); } };
        rd_sel(0); ldk(0); ldv(0);
#pragma unroll 1
        for (int i = 0; i < 32; ++i) {
            const int hh = i & 1;
            myblk = mytok == 0 ? blk[0] : (mytok == 1 ? blk[1] : (mytok == 2 ? blk[2] : blk[3]));
            f32x4 acc[2] = {zs, zs};
#pragma unroll
            for (int tq = 0; tq < 4; ++tq) { const unsigned msk = (mytok == tq) ? 0xffffffffu : 0u;
                bf16x8 qm[2];
#pragma unroll
                for (int s2 = 0; s2 < 2; ++s2) { u32x4t w = __builtin_bit_cast(u32x4t, qc[s2]); w.x &= msk; w.y &= msk; w.z &= msk; w.w &= msk; qm[s2] = __builtin_bit_cast(bf16x8, w); }
                acc[0] = MFMA16(kf[tq][0][0], qm[0], acc[0]); acc[1] = MFMA16(kf[tq][1][0], qm[0], acc[1]);
                acc[0] = MFMA16(kf[tq][0][1], qm[1], acc[0]); acc[1] = MFMA16(kf[tq][1][1], qm[1], acc[1]); }
            const int kp0 = 64 * myblk + 32 * hh + 8 * rg; const bool live = myblk >= 0;
            int nblk[4];
            { const int rn = (i + 1 < 32 ? i + 1 : i) >> 1;
#pragma unroll
              for (int tq = 0; tq < 4; ++tq) nblk[tq] = __builtin_amdgcn_readfirstlane(sel[(4 * ct + tq) * 16 + rn]); }
            int cblk[4];
#pragma unroll
            for (int tq = 0; tq < 4; ++tq) { cblk[tq] = blk[tq]; blk[tq] = nblk[tq]; }
            ldk((i + 1 < 32 ? i + 1 : i) & 1);
#pragma unroll
            for (int j = 0; j < 8; ++j) { const int d = qpc - (kp0 + j); const float add = (live && d >= 0) ? tab[t5b(d)] : -INFINITY; if (j < 4) acc[0][j] += add; else acc[1][j - 4] += add; }
            const bf16x8 p = att_softmax_ref(ss, acc[0], acc[1]);
#pragma unroll
            for (int tq = 0; tq < 4; ++tq) { const unsigned msk = (mytok == tq) ? 0xffffffffu : 0u; u32x4t w = __builtin_bit_cast(u32x4t, p); w.x &= msk; w.y &= msk; w.z &= msk; w.w &= msk;
                const bf16x8 pm = __builtin_bit_cast(bf16x8, w);
#pragma unroll
                for (int dt = 0; dt < 4; ++dt) ss.ot[dt] = MFMA16(vf[tq][dt], pm, ss.ot[dt]); }
            (void)cblk;
            ldv((i + 1 < 32 ? i + 1 : i) & 1);
        }
        att_finish(ss, g1c);
#pragma unroll
        for (int dt = 0; dt < 4; ++dt) { LAS f32x4* op = (LAS f32x4*)(outl + (16 * ct + n) * 68 + 16 * dt + 4 * rg); *op = *op + ss.ot[dt]; }
    }
    {
        const bf16* Kw = QK + (size_t)b * T * NQK + C_KWA + g * 64; const bf16* Vw = VT + (size_t)(R_VWA + g * 64) * M + (size_t)b * T;
        bf16x8 qf[2][2]; load_q(qf[0], 0); load_q(qf[1], 1);
        att_init(st[0]); att_init(st[1]);
        const float kmw = sqrtf(__uint_as_float(KMX[b * 28 + 26 + g])) * 1.0001f;
        const int h0 = (t0 - 511) < 0 ? 0 : ((t0 - 511) >> 5), h1 = (t0 + 7) >> 5;
        { auto wstep = [&](const KVFrag& f, int hc) {
#pragma unroll
            for (int ct = 0; ct < 2; ++ct) { const float nrw = -(qn[ct] * kmw + tmx); const f32x4 zw = {nrw, nrw, nrw, nrw}; f32x4 acc[2]; att_qk(acc, f, qf[ct], zw, zw);
                const int kp0 = 32 * hc + 8 * rg;
#pragma unroll
                for (int i = 0; i < 8; ++i) { const int d = qpos[ct] - (kp0 + i); const float add = (d >= 0 && d <= 511) ? tab[t5b(d)] : -INFINITY; if (i < 4) acc[0][i] += add; else acc[1][i - 4] += add; }
                const bf16x8 p = att_softmax_ref(st[ct], acc[0], acc[1]); att_pv(st[ct], f, p); }
            };
          KVFrag fa, fb; kv_load(fa, Kw, NQK, Vw, M, 32 * h0, n, rg);
          for (int hc = h0; hc <= h1; hc += 2) { kv_load(fb, Kw, NQK, Vw, M, 32 * (hc + 1 <= h1 ? hc + 1 : hc), n, rg); wstep(fa, hc); if (hc + 1 > h1) break;
              kv_load(fa, Kw, NQK, Vw, M, 32 * (hc + 2 <= h1 ? hc + 2 : hc + 1), n, rg); wstep(fb, hc + 1); } }
#pragma unroll
        for (int ct = 0; ct < 2; ++ct) { att_finish(st[ct], gate[2][ct]);
            bf16* orow = OB + (size_t)(b * T + qpos[ct]) * DM + hd * 64 + 4 * rg;
#pragma unroll
            for (int dt = 0; dt < 4; ++dt) { const f32x4 o = *(const LAS f32x4*)(outl + (16 * ct + n) * 68 + 16 * dt + 4 * rg) + st[ct].ot[dt];
                v2u w; w.x = cvt_pk(o[0], o[1]); w.y = cvt_pk(o[2], o[3]); *(v2u*)(orow + 16 * dt) = w; } }
    }
    LDS_WAIT();
}


__device__ __forceinline__ float gelu_fast(float x) { const float u = 0.7978845608028654f * (x + 0.044715f * x * x * x); return x / (1.f + exp2f(-2.f * LOG2E * u)); }
__device__ __forceinline__ void compress_unit(LAS unsigned char* L, int which, int bg, int cb, const bf16* QK, const bf16* W1t, const bf16* W2t, const float* hb, bf16* KC, bf16* VCT, int wave, int lane) {
    const int n = lane & 15, rg = lane >> 4, b = bg >> 1, g = bg & 1, col = (which ? C_VCA : C_KCA) + g * 64, n0 = 32 * wave;
    f32x4 acc[2][2];
#pragma unroll
    for (int i = 0; i < 2; ++i)
#pragma unroll
        for (int j = 0; j < 2; ++j) acc[i][j] = (f32x4){0.f, 0.f, 0.f, 0.f};
    const bf16* ap[2]; const bf16* bp[2];
#pragma unroll
    for (int i = 0; i < 2; ++i) { ap[i] = W1t + (size_t)(n0 + 16 * i + n) * 2048 + 8 * rg;
        int c = 32 * cb + 16 * i + n; c = c > 510 ? 510 : c; bp[i] = QK + (size_t)(b * T + 16 * c) * NQK + col + 8 * rg; }
#pragma unroll 4
    for (int s = 0; s < 64; ++s) { bf16x8 af[2], bf[2];
#pragma unroll
        for (int i = 0; i < 2; ++i) { af[i] = ld16(ap[i] + 32 * s); bf[i] = ld16(bp[i] + (size_t)(s >> 1) * NQK + 32 * (s & 1)); }
#pragma unroll
        for (int i = 0; i < 2; ++i)
#pragma unroll
            for (int j = 0; j < 2; ++j) acc[i][j] = MFMA16(af[i], bf[j], acc[i][j]); }
    LAS unsigned char* hid = L;
#pragma unroll
    for (int i = 0; i < 2; ++i) { const f32x4 hbv = *(const f32x4*)(hb + n0 + 16 * i + 4 * rg);
#pragma unroll
        for (int j = 0; j < 2; ++j) { const f32x4 v = acc[i][j] + hbv; v2u w; w.x = cvt_pk(gelu_fast(v[0]), gelu_fast(v[1])); w.y = cvt_pk(gelu_fast(v[2]), gelu_fast(v[3]));
            *(LAS v2u*)(hid + (16 * j + n) * 528 + (n0 + 16 * i + 4 * rg) * 2) = w; } }
    __syncthreads();
    const int ct2 = wave >> 2, dt = wave & 3;
    f32x4 o = {0.f, 0.f, 0.f, 0.f};
#pragma unroll
    for (int s = 0; s < 8; ++s) { const bf16x8 hf = *(const LAS bf16x8*)(hid + (16 * ct2 + n) * 528 + (32 * s + 8 * rg) * 2); const bf16x8 wf = ld16(W2t + (size_t)(16 * dt + n) * 256 + 32 * s + 8 * rg);
        o = which ? MFMA16(hf, wf, o) : MFMA16(wf, hf, o); }
    if (!which) { const int c = 32 * cb + 16 * ct2 + n; v2u w; w.x = cvt_pk(o[0], o[1]); w.y = cvt_pk(o[2], o[3]); if (c == 511) { w.x = 0u; w.y = 0u; }
        *(v2u*)(KC + ((size_t)bg * 512 + c) * 64 + 16 * dt + 4 * rg) = w; }
    else { const int c = 32 * cb + 16 * ct2 + 4 * rg; v2u w; w.x = cvt_pk(o[0], o[1]); w.y = cvt_pk(o[2], c + 3 == 511 ? 0.f : o[3]);
        *(v2u*)(VCT + ((size_t)bg * 64 + 16 * dt + n) * 512 + c) = w; }
    __syncthreads();
}
__device__ __forceinline__ float log_sigmoid_f(float x) { return x >= 0.f ? -log1pf(__expf(-x)) : x - log1pf(__expf(x)); }
__device__ __forceinline__ void cumsum_unit(LAS unsigned char* L, const bf16* fcrow, float fb, float* cum, int tid) {
    const int lane = tid & 63, wave = tid >> 6;
    float v[16]; const v4u* p = (const v4u*)(fcrow + tid * 16); const v4u w0 = p[0], w1 = p[1];
    const unsigned ww[8] = {w0.x, w0.y, w0.z, w0.w, w1.x, w1.y, w1.z, w1.w};
    float run = 0.f;
#pragma unroll
    for (int i = 0; i < 8; ++i) { run += log_sigmoid_f(bf_lo(ww[i]) + fb); v[2 * i] = run; run += log_sigmoid_f(bf_hi(ww[i]) + fb); v[2 * i + 1] = run; }
    float incl = run;
#pragma unroll
    for (int o = 1; o < 64; o <<= 1) { const float u = __shfl_up(incl, o); if (lane >= o) incl += u; }
    LAS float* wt = (LAS float*)L;
    if (lane == 63) wt[wave] = incl;
    __syncthreads();
    float base = incl - run;
    for (int w = 0; w < wave; ++w) base += wt[w];
    f32x4* o4 = (f32x4*)(cum + tid * 16);
#pragma unroll
    for (int i = 0; i < 4; ++i) o4[i] = (f32x4){(base + v[4 * i]) * LOG2E, (base + v[4 * i + 1]) * LOG2E, (base + v[4 * i + 2]) * LOG2E, (base + v[4 * i + 3]) * LOG2E};
    __syncthreads();
}


constexpr int NSA_MASK_OFF = 4096, NSA_LUT_OFF = 8192, NSA_LUT_PAD = 64, NSA_LUT_N = 3072, NSA_ST_OFF = 8192 + 4 * NSA_LUT_N * 4, NSA_IMP_OFF = NSA_ST_OFF + 32768, NSA_WIN_BUF = 32768;
static_assert(NSA_ST_OFF + 2 * NSA_WIN_BUF <= RING_BYTES && NSA_IMP_OFF + 8 * 4096 <= NSA_ST_OFF + 2 * NSA_WIN_BUF, "NSA LDS map");
__device__ __forceinline__ int swz7(int r) { return ((r >> 4) & 1) * 5 + ((r >> 1) & 1) * 2; }
__device__ __forceinline__ int swzv(int d) { return ((d >> 3) & 1) * 5 + ((d >> 1) & 1) * 2; }
__device__ __forceinline__ void nsa_build_lut(LAS unsigned char* L, const LAS float* tabs, int g, int tid) {
    LAS float* lut = (LAS float*)(L + NSA_LUT_OFF);
    for (int j = tid; j < NSA_LUT_N; j += NTHR) { const int d = j - NSA_LUT_PAD, bk = t5b(d);
#pragma unroll
        for (int hl = 0; hl < 4; ++hl) lut[hl * NSA_LUT_N + j] = d >= 0 ? tabs[(4 * g + hl) * 32 + bk] : -INFINITY; }
}
__device__ __forceinline__ void att_nsa_coop_unit(LAS unsigned char* L, int b, int g, int t0, int tid, const bf16* QK, const bf16* VT, const bf16* KC, const bf16* VCT, bf16* OB, const LAS float* tabs, const unsigned* KMX, unsigned* NMSK) {
    asm volatile("" : "+v"(tid));
    const int lane = tid & 63, wave = __builtin_amdgcn_readfirstlane(tid >> 6), n = lane & 15, rg = lane >> 4, bg = b * 2 + g, hd = 4 * g + (n & 3), tw0 = t0 + 8 * wave;
    const LAS float* tab = tabs + hd * 32;
    const LAS float* lut = (const LAS float*)(L + NSA_LUT_OFF) + (n & 3) * NSA_LUT_N + NSA_LUT_PAD;
    LAS unsigned char* stb = L + NSA_ST_OFF;
    LAS float* imp = (LAS float*)(L + NSA_IMP_OFF) + wave * 1024;
    LAS unsigned* msk = (LAS unsigned*)(L + NSA_MASK_OFF) + wave * 32;
    bf16x8 qf[2][2]; int qpos[2]; float gate[3][2], qn[2];
#pragma unroll
    for (int ct = 0; ct < 2; ++ct) { const int tk = tw0 + 4 * ct + (n >> 2); qpos[ct] = tk;
#pragma unroll
        for (int s = 0; s < 2; ++s) qf[ct][s] = ld16(QK + (size_t)(b * T + tk) * NQK + C_QA + hd * 64 + 32 * s + 8 * rg);
        qn[ct] = q_norm(qf[ct]);
#pragma unroll
        for (int br = 0; br < 3; ++br) gate[br][ct] = sigmoidf(bf2f(VT[(size_t)(R_GA + br * 8 + hd) * M + (size_t)b * T + tk])); }
    const float tmx = tabs[768 + hd];
#pragma unroll
    for (int i = 0; i < 16; ++i) imp[lane + 64 * i] = 0.f;
    f32x4 outv[2][4];
    const f32x4 z4 = {0.f, 0.f, 0.f, 0.f};
    const int lrow = tid >> 3, lch = tid & 7;
    const int lofk = 128 * lrow + 16 * (lch ^ swz7(lrow)), lofv = 8192 + 128 * lrow + 16 * (lch ^ swzv(lrow));
    int kro[2][2], vro[2][4];
#pragma unroll
    for (int e = 0; e < 2; ++e) { const int rho = 8 * (n >> 2) + 4 * e + (n & 3);
#pragma unroll
        for (int s = 0; s < 2; ++s) kro[e][s] = 128 * rho + 16 * ((4 * s + rg) ^ swz7(rho)); }
#pragma unroll
    for (int hh = 0; hh < 2; ++hh)
#pragma unroll
        for (int dt = 0; dt < 4; ++dt) { const int d = 16 * dt + n; vro[hh][dt] = 8192 + 128 * d + 16 * ((4 * hh + rg) ^ swzv(d)); }
    auto ldfrag = [&](KVFrag& f, const LAS unsigned char* buf, int hh) {
#pragma unroll
        for (int e = 0; e < 2; ++e)
#pragma unroll
            for (int s = 0; s < 2; ++s) f.k[e][s] = *(const LAS bf16x8*)(buf + 4096 * hh + kro[e][s]);
#pragma unroll
        for (int dt = 0; dt < 4; ++dt) f.v[dt] = *(const LAS bf16x8*)(buf + vro[hh][dt]); };
#define NSA_STREAM(KB_, KPB_, VB_, VPB_, HFIRST_, HLAST_, NEED_, BODY_) do { \
        const char* gk_ = (const char*)(KB_) + (size_t)lrow * (KPB_) + 16 * lch; const char* gv_ = (const char*)(VB_) + (size_t)lrow * (VPB_) + 16 * lch; \
        const size_t gks_ = (size_t)64 * (KPB_); const int hf_ = (HFIRST_), hl_ = (HLAST_); \
        int kt_ = hf_ >> 1; const int ktl_ = hl_ >> 1; \
        { const v4u rk_ = *(const v4u*)(gk_ + (size_t)kt_ * gks_), rv_ = *(const v4u*)(gv_ + (size_t)kt_ * 128); *(LAS v4u*)(stb + lofk) = rk_; *(LAS v4u*)(stb + lofv) = rv_; } \
        __syncthreads(); \
        for (int par_ = 0;; par_ ^= 1) { const int nx_ = kt_ < ktl_ ? kt_ + 1 : kt_; \
            const v4u rk_ = *(const v4u*)(gk_ + (size_t)nx_ * gks_), rv_ = *(const v4u*)(gv_ + (size_t)nx_ * 128); \
            _Pragma("unroll") for (int hh_ = 0; hh_ < 2; ++hh_) { const int hc_ = 2 * kt_ + hh_; if (hc_ >= hf_ && hc_ <= hl_ && NEED_(hc_)) { BODY_(stb + par_ * 16384, hh_, hc_); } } \
            *(LAS v4u*)(stb + (par_ ^ 1) * 16384 + lofk) = rk_; *(LAS v4u*)(stb + (par_ ^ 1) * 16384 + lofv) = rv_; \
            __syncthreads(); \
            if (kt_ >= ktl_) break; kt_ = nx_; } } while (0)
    AttSt st[2]; att_init(st[0]); att_init(st[1]);
    const bf16* Kc = KC + (size_t)bg * 512 * 64; const bf16* Vc = VCT + (size_t)bg * 64 * 512;
    const int cmaxu = (t0 + 63 - 31) >> 4, cmaxw = (tw0 + 7 - 31) >> 4;
    auto cmp_fix = [&](f32x4 (&acc)[2], int k0, int qp) {
        const int d0 = qp - 31 - 16 * k0;
#pragma unroll
        for (int i = 0; i < 8; ++i) { int dc = d0 - 16 * i; dc = dc < -1 ? -1 : (dc > 3000 ? 3000 : dc); const float add = lut[dc]; if (i < 4) acc[0][i] += add; else acc[1][i - 4] += add; } };
    float mfin[2] = {0.f, 0.f}, linv[2] = {0.f, 0.f};
    {
        const int nhu = (cmaxu >> 5) + 1;
        auto need_c = [&](int hc) -> bool { return cmaxw >= 0 && hc <= (cmaxw >> 5); };
        auto body1 = [&](const LAS unsigned char* buf, int hh, int hc) { KVFrag f; ldfrag(f, buf, hh);
#pragma unroll
            for (int ct = 0; ct < 2; ++ct) { f32x4 acc[2]; att_qk(acc, f, qf[ct], z4, z4); cmp_fix(acc, 32 * hc + 8 * rg, qpos[ct]); const bf16x8 p = att_softmax(st[ct], acc[0], acc[1]); att_pv(st[ct], f, p); } };
        NSA_STREAM(Kc, 128, Vc, 1024, 0, nhu - 1, need_c, body1);
#pragma unroll
        for (int ct = 0; ct < 2; ++ct) { const float lt = rg_sum(st[ct].l); linv[ct] = lt > 0.f ? 1.f / lt : 0.f; mfin[ct] = st[ct].m == -INFINITY ? 0.f : st[ct].m; }
        float carry[2] = {0.f, 0.f};
        auto body2 = [&](const LAS unsigned char* buf, int hh, int hc) { KVFrag f; ldfrag(f, buf, hh);
#pragma unroll
            for (int ct = 0; ct < 2; ++ct) { f32x4 acc[2]; att_qk(acc, f, qf[ct], z4, z4); cmp_fix(acc, 32 * hc + 8 * rg, qpos[ct]);
                float pe[8];
#pragma unroll
                for (int i = 0; i < 4; ++i) { pe[i] = __builtin_amdgcn_exp2f(acc[0][i] - mfin[ct]) * linv[ct]; pe[4 + i] = __builtin_amdgcn_exp2f(acc[1][i] - mfin[ct]) * linv[ct]; }
                float G0 = (pe[0] + pe[1]) + (pe[2] + pe[3]), L0 = pe[3], G1 = (pe[4] + pe[5]) + (pe[6] + pe[7]), L1 = pe[7];
                G0 += __shfl_xor(G0, 1); G0 += __shfl_xor(G0, 2); L0 += __shfl_xor(L0, 1); L0 += __shfl_xor(L0, 2);
                G1 += __shfl_xor(G1, 1); G1 += __shfl_xor(G1, 2); L1 += __shfl_xor(L1, 1); L1 += __shfl_xor(L1, 2);
                float Lp = __shfl_up(L1, 16); if (rg == 0) Lp = carry[ct];
                carry[ct] = __shfl(L1, (lane + 48) & 63);
                if ((n & 3) == 0) { LAS float* ip = imp + (4 * ct + (n >> 2)) * 128 + 8 * hc + 2 * rg; ip[0] = G0 + Lp; ip[1] = G1 + L0; } } };
        NSA_STREAM(Kc, 128, Vc, 1024, 0, nhu - 1, need_c, body2);
        if (cmaxw >= 0 && rg == 0 && (n & 3) == 0) { const int nbx = 8 * ((cmaxw >> 5) + 1);
            if (nbx < 128) {
#pragma unroll
                for (int ct = 0; ct < 2; ++ct) imp[(4 * ct + (n >> 2)) * 128 + nbx] = carry[ct]; } }
    }
#pragma unroll
    for (int ct = 0; ct < 2; ++ct) { att_finish(st[ct], gate[0][ct]);
#pragma unroll
        for (int dt = 0; dt < 4; ++dt) outv[ct][dt] = st[ct].ot[dt]; }
    LDS_WAIT();
    {
        const int tki = lane >> 3, sub = lane & 7, tk = tw0 + tki, cur = tk >> 6;
        unsigned key[16];
#pragma unroll
        for (int k4 = 0; k4 < 4; ++k4) { const f32x4 v = *(const LAS f32x4*)(imp + tki * 128 + sub * 16 + 4 * k4);
#pragma unroll
            for (int i = 0; i < 4; ++i) { const int nb = sub * 16 + 4 * k4 + i; const bool forced = nb == 0 || nb == cur || nb == cur - 1;
                key[4 * k4 + i] = nb > cur ? 0u : (forced ? (0x7f000000u | (unsigned)(127 - nb)) : ((__float_as_uint(v[i]) & ~127u) | (unsigned)(127 - nb))); } }
        unsigned mword = 0u;
        for (int r = 0; r < 16; ++r) { unsigned mx = key[0];
#pragma unroll
            for (int i = 1; i < 16; ++i) mx = key[i] > mx ? key[i] : mx;
            unsigned w;
            w = __shfl_xor(mx, 1); mx = w > mx ? w : mx; w = __shfl_xor(mx, 2); mx = w > mx ? w : mx; w = __shfl_xor(mx, 4); mx = w > mx ? w : mx;
            if (mx) { const int nsel = (int)(127u - (mx & 127u)); if ((nsel >> 5) == sub) mword |= 1u << (nsel & 31); }
#pragma unroll
            for (int i = 0; i < 16; ++i) key[i] = key[i] == mx ? 0u : key[i]; }
        if (sub < 4) { msk[tki * 4 + sub] = mword; NMSK[((size_t)bg * T + tw0 + tki) * 4 + sub] = mword; }
    }
    {
        const bf16* Kw = QK + (size_t)b * T * NQK + C_KWA + g * 64; const bf16* Vw = VT + (size_t)(R_VWA + g * 64) * M + (size_t)b * T;
        att_init(st[0]); att_init(st[1]);
        const float kmw = sqrtf(__uint_as_float(KMX[b * 28 + 26 + g])) * 1.0001f;
        const int h0u = (t0 - 511) < 0 ? 0 : ((t0 - 511) >> 5), h1u = (t0 + 63) >> 5, h0w = (tw0 - 511) < 0 ? 0 : ((tw0 - 511) >> 5), h1w = (tw0 + 7) >> 5;
        auto need_w = [&](int hc) -> bool { return hc >= h0w && hc <= h1w; };
        auto bodyw = [&](const LAS unsigned char* buf, int hh, int hc) { KVFrag f; ldfrag(f, buf, hh);
#pragma unroll
            for (int ct = 0; ct < 2; ++ct) { const float nrw = -(qn[ct] * kmw + tmx); const f32x4 zw = {nrw, nrw, nrw, nrw}; f32x4 acc[2]; att_qk(acc, f, qf[ct], zw, zw);
                const int dl = qpos[ct] - (32 * hc + 8 * rg); const LAS float* lp = lut + dl - 7;
#pragma unroll
                for (int i = 0; i < 8; ++i) { float add = lp[7 - i]; if (hc <= h0w + 1 && dl - i > 511) add = -INFINITY; if (i < 4) acc[0][i] += add; else acc[1][i - 4] += add; }
                const bf16x8 p = att_softmax_refm(acc[0], acc[1]); att_pv_l(st[ct], f, p); } };
        NSA_STREAM(Kw, (size_t)NQK * 2, Vw, (size_t)M * 2, h0u, h1u, need_w, bodyw);
#pragma unroll
        for (int ct = 0; ct < 2; ++ct) { att_finish_l(st[ct], gate[2][ct]);
            bf16* orow = OB + (size_t)(b * T + qpos[ct]) * DM + hd * 64 + 4 * rg;
#pragma unroll
            for (int dt = 0; dt < 4; ++dt) { const f32x4 o = outv[ct][dt] + st[ct].ot[dt]; v2u wv; wv.x = cvt_pk(o[0], o[1]); wv.y = cvt_pk(o[2], o[3]); *(v2u*)(orow + 16 * dt) = wv; } }
    }
    __syncthreads();
#undef NSA_STREAM
}


__device__ __forceinline__ void nsa_sel128_unit(LAS unsigned char* L, int b, int g, int t0, int tid, const bf16* QK, const bf16* VT, bf16* OB, const LAS float* tabs, const unsigned* KMX, const unsigned* NMSK) {
    asm volatile("" : "+v"(tid));
    const int lane = tid & 63, wave = __builtin_amdgcn_readfirstlane(tid >> 6), n = lane & 15, rg = lane >> 4, bg = b * 2 + g, hd = 4 * g + (n & 3), tw0 = t0 + 16 * wave;
    const LAS float* lut = (const LAS float*)(L + NSA_LUT_OFF) + (n & 3) * NSA_LUT_N + NSA_LUT_PAD;
    LAS unsigned char* stb = L + NSA_ST_OFF;
    LAS unsigned* msk = (LAS unsigned*)(L + NSA_MASK_OFF) + wave * 64;
    msk[lane] = NMSK[((size_t)bg * T + tw0 + (lane >> 2)) * 4 + (lane & 3)];
    const float tmx = tabs[768 + hd], kms = sqrtf(__uint_as_float(KMX[b * 28 + 24 + g])) * 1.0001f;
    bf16x8 qf[4][2]; int qpos[4]; float nrs[4];
#pragma unroll
    for (int ct = 0; ct < 4; ++ct) { const int tk = tw0 + 4 * ct + (n >> 2); qpos[ct] = tk;
#pragma unroll
        for (int s = 0; s < 2; ++s) qf[ct][s] = ld16(QK + (size_t)(b * T + tk) * NQK + C_QA + hd * 64 + 32 * s + 8 * rg);
        nrs[ct] = -(q_norm(qf[ct]) * kms + tmx); }
    int kro[2][2];
#pragma unroll
    for (int e = 0; e < 2; ++e) { const int rho = 8 * (n >> 2) + 4 * e + (n & 3);
#pragma unroll
        for (int s = 0; s < 2; ++s) kro[e][s] = 128 * rho + 16 * ((4 * s + rg) ^ swz7(rho)); }
    const char* Ks = (const char*)(QK + (size_t)b * T * NQK + C_KSA + g * 64); const char* Vs = (const char*)(VT + (size_t)(R_VSA + g * 64) * M + (size_t)b * T);
    const int nwin = ((t0 + 127) >> 7) + 1;
    AttSt ss[4];
#pragma unroll
    for (int ct = 0; ct < 4; ++ct) att_init(ss[ct]);
    int wl_l[4]; size_t wl_g[4]; bool wl_k[4];
#pragma unroll
    for (int j = 0; j < 4; ++j) { const int q = tid + 512 * j; const bool kk = q < 1024; const int q2 = q & 1023, bi = q2 >> 9, row = (q2 >> 3) & 63, c = q2 & 7; wl_k[j] = kk;
        wl_l[j] = bi * 16384 + (kk ? 0 : 8192) + 128 * row + 16 * (c ^ (kk ? swz7(row) : swzv(row)));
        wl_g[j] = kk ? (size_t)(64 * bi + row) * (NQK * 2) + 16 * c : (size_t)row * ((size_t)M * 2) + (size_t)(64 * bi) * 2 + 16 * c; }
    auto wload = [&](v4u (&r)[4], int w) {
#pragma unroll
        for (int j = 0; j < 4; ++j) r[j] = *(const v4u*)((wl_k[j] ? Ks + (size_t)(128 * w) * (NQK * 2) : Vs + (size_t)(128 * w) * 2) + wl_g[j]); };
    auto wstore = [&](const v4u (&r)[4], int par) {
#pragma unroll
        for (int j = 0; j < 4; ++j) *(LAS v4u*)(stb + par * NSA_WIN_BUF + wl_l[j]) = r[j]; };
    const int mytok = n >> 2;
    { v4u r[4]; wload(r, 0); wstore(r, 0); }
    __syncthreads();
    int w = 0;
    unsigned anyw[4] = {0u, 0u, 0u, 0u}, myw[4] = {0u, 0u, 0u, 0u};
    for (int par = 0;; par ^= 1) {
        const int nw = w + 1 < nwin ? w + 1 : w;
        v4u r[4]; wload(r, nw);
        const LAS unsigned char* wb = stb + par * NSA_WIN_BUF;
        if ((w & 15) == 0) {
#pragma unroll
            for (int ct = 0; ct < 4; ++ct) { anyw[ct] = 0u; myw[ct] = 0u;
#pragma unroll
                for (int tq = 0; tq < 4; ++tq) { const unsigned bt = __builtin_amdgcn_readfirstlane(msk[(4 * ct + tq) * 4 + (w >> 4)]); anyw[ct] |= bt; myw[ct] = (mytok == tq) ? bt : myw[ct]; } } }
        unsigned anyb[4], mybits[4];
#pragma unroll
        for (int ct = 0; ct < 4; ++ct) { anyb[ct] = (anyw[ct] >> (2 * (w & 15))) & 3u; mybits[ct] = (myw[ct] >> (2 * (w & 15))) & 3u; }
        for (int bl = 0; bl < 2; ++bl) {
            if ((((anyb[0] | anyb[1] | anyb[2] | anyb[3]) >> bl) & 1u) == 0u) continue;
#pragma unroll
            for (int hh = 0; hh < 2; ++hh) {
                KVFrag f; const LAS unsigned char* kb = wb + bl * 16384 + 4096 * hh; const LAS unsigned char* vb = wb + bl * 16384 + 8192;
#pragma unroll
                for (int e = 0; e < 2; ++e)
#pragma unroll
                    for (int s = 0; s < 2; ++s) f.k[e][s] = *(const LAS bf16x8*)(kb + kro[e][s]);
#pragma unroll
                for (int dt = 0; dt < 4; ++dt) { const int d = 16 * dt + n; f.v[dt] = *(const LAS bf16x8*)(vb + 128 * d + 16 * ((4 * hh + rg) ^ swzv(d))); }
#pragma unroll
                for (int ct = 0; ct < 4; ++ct) {
                    if (((anyb[ct] >> bl) & 1u) == 0u) continue;
                    const float ini = ((mybits[ct] >> bl) & 1u) ? nrs[ct] : -INFINITY; const f32x4 zi = {ini, ini, ini, ini};
                    f32x4 acc[2]; att_qk(acc, f, qf[ct], zi, zi);
                    int dl = qpos[ct] - (64 * (2 * w + bl) + 32 * hh + 8 * rg); dl = dl > 3000 ? 3000 : dl;
                    const LAS float* lp = lut + dl - 7;
#pragma unroll
                    for (int i = 0; i < 8; ++i) { const float add = lp[7 - i]; if (i < 4) acc[0][i] += add; else acc[1][i - 4] += add; }
                    const bf16x8 p = att_softmax_refm(acc[0], acc[1]); att_pv_l(ss[ct], f, p); }
            }
        }
        wstore(r, par ^ 1);
        __syncthreads();
        if (w + 1 >= nwin) break;
        w = nw;
    }
#pragma unroll
    for (int ct = 0; ct < 4; ++ct) { att_finish_l(ss[ct], sigmoidf(bf2f(VT[(size_t)(R_GA + 8 + hd) * M + (size_t)b * T + qpos[ct]])));
        bf16* orow = OB + (size_t)(b * T + qpos[ct]) * DM + hd * 64 + 4 * rg;
#pragma unroll
        for (int dt = 0; dt < 4; ++dt) { const v2u pv = *(const v2u*)(orow + 16 * dt); const f32x4 o = ss[ct].ot[dt] + (f32x4){bf_lo(pv.x), bf_hi(pv.x), bf_lo(pv.y), bf_hi(pv.y)};
            v2u wv; wv.x = cvt_pk(o[0], o[1]); wv.y = cvt_pk(o[2], o[3]); *(v2u*)(orow + 16 * dt) = wv; } }
}

constexpr int FOX_OFF = 8192;
template <int NB, int NQ>
__device__ __forceinline__ void att_fox_unit(LAS unsigned char* L, int b, int h, int u256, int tid, const bf16* QK, const bf16* VT, const float* CUM, bf16* OB, const unsigned* KMX) {
    asm volatile("" : "+v"(tid));
    constexpr int BUFSZ = NB * 16384 + 1024, CUM_OFF = NB * 16384;
    const int lane = tid & 63, wave = __builtin_amdgcn_readfirstlane(tid >> 6), n = lane & 15, rg = lane >> 4, q0 = (8 * u256 + wave) * 16 * NQ;
    const char* Kb = (const char*)(QK + (size_t)b * T * NQK + C_KC + h * 64); const char* Vb = (const char*)(VT + (size_t)(R_VC + h * 64) * M + (size_t)b * T);
    const float* cum = CUM + (size_t)(b * 8 + h) * T;
    bf16x8 qf[NQ][2];
#pragma unroll
    for (int ct = 0; ct < NQ; ++ct)
#pragma unroll
        for (int s = 0; s < 2; ++s) qf[ct][s] = ld16(QK + (size_t)(b * T + q0 + 16 * ct + n) * NQK + C_QC + h * 64 + 32 * s + 8 * rg);
    AttSt st[NQ];
#pragma unroll
    for (int ct = 0; ct < NQ; ++ct) att_init(st[ct]);
    const float kmx = sqrtf(__uint_as_float(KMX[b * 28 + 8 + h])) * 1.0001f;
    float base[NQ];
#pragma unroll
    for (int ct = 0; ct < NQ; ++ct) base[ct] = cum[q0 + 16 * ct + n] - q_norm(qf[ct]) * kmx;
    const int rowl = 8 * wave + (lane >> 3), cl = lane & 7;
    const char* gk = Kb + (size_t)rowl * (NQK * 2) + 16 * (cl ^ swz7(rowl)); const size_t gks = (size_t)64 * NQK * 2;
    const char* gv = Vb + (size_t)rowl * ((size_t)M * 2) + 16 * (cl ^ swzv(rowl)); const size_t gvs = 128;
    int kro[2][2], vro[2][4];
#pragma unroll
    for (int e = 0; e < 2; ++e) { const int rho = 8 * (n >> 2) + 4 * e + (n & 3);
#pragma unroll
        for (int s = 0; s < 2; ++s) kro[e][s] = 128 * rho + 16 * ((4 * s + rg) ^ swz7(rho)); }
#pragma unroll
    for (int hh = 0; hh < 2; ++hh)
#pragma unroll
        for (int dt = 0; dt < 4; ++dt) { const int d = 16 * dt + n; vro[hh][dt] = 8192 + 128 * d + 16 * ((4 * hh + rg) ^ swzv(d)); }
    const int nt = (2 * NQ * (u256 + 1)) / NB;
    LAS unsigned char* tb = L + FOX_OFF;
    auto tdma = [&](int kt, int pb) {
#pragma unroll
        for (int bl = 0; bl < NB; ++bl) {
            __builtin_amdgcn_global_load_lds((const unsigned*)(gk + (size_t)(NB * kt + bl) * gks), (LAS unsigned*)(tb + pb * BUFSZ + 16384 * bl + wave * 1024), 16, 0, 0);
            __builtin_amdgcn_global_load_lds((const unsigned*)(gv + (size_t)(NB * kt + bl) * gvs), (LAS unsigned*)(tb + pb * BUFSZ + 16384 * bl + 8192 + wave * 1024), 16, 0, 0); } };
    {   float rc = 0.f; if (tid < 64 * NB) rc = cum[tid];
        tdma(0, 0);
        if (tid < 64 * NB) *(LAS float*)(tb + CUM_OFF + 4 * tid) = rc;
        asm volatile("s_waitcnt vmcnt(0)" ::: "memory"); }
    __syncthreads();
    for (int kt = 0, par = 0;; ++kt, par ^= 1) {
        const int nx = kt + 1 < nt ? kt + 1 : kt;
        float rc = 0.f; if (tid < 64 * NB) rc = cum[64 * NB * nx + tid];
        if (kt + 1 < nt) tdma(nx, par ^ 1);
        const LAS unsigned char* buf = tb + par * BUFSZ;
#pragma unroll 1
        for (int hh = 0; hh < 2 * NB; ++hh) { const int hc = 2 * NB * kt + hh;
            if (32 * hc <= q0 + 16 * NQ - 1) { KVFrag f; const LAS unsigned char* bb_ = buf + 16384 * (hh >> 1);
#pragma unroll
                for (int e = 0; e < 2; ++e)
#pragma unroll
                    for (int s = 0; s < 2; ++s) f.k[e][s] = *(const LAS bf16x8*)(bb_ + 4096 * (hh & 1) + kro[e][s]);
#pragma unroll
                for (int dt = 0; dt < 4; ++dt) f.v[dt] = *(const LAS bf16x8*)(bb_ + (vro[0][dt] ^ ((hh & 1) << 6)));
                const f32x4 c0 = *(const LAS f32x4*)(buf + CUM_OFF + 4 * (32 * hh + 8 * rg)), c1 = *(const LAS f32x4*)(buf + CUM_OFF + 4 * (32 * hh + 8 * rg + 4));
                const int k0 = 32 * hc + 8 * rg;
#pragma unroll
                for (int ct = 0; ct < NQ; ++ct) { if (32 * hc > q0 + 16 * ct + 15) continue;
                    const f32x4 bb = {base[ct], base[ct], base[ct], base[ct]}; f32x4 acc[2]; att_qk(acc, f, qf[ct], bb - c0, bb - c1);
                    if (32 * hc + 31 > q0 + 16 * ct) { const int qp = q0 + 16 * ct + n;
#pragma unroll
                        for (int i = 0; i < 4; ++i) { if (k0 + i > qp) acc[0][i] = -INFINITY; if (k0 + 4 + i > qp) acc[1][i] = -INFINITY; } }
                    const bf16x8 p = att_softmax_refm(acc[0], acc[1]); att_pv_l(st[ct], f, p); } } }
        if (tid < 64 * NB) *(LAS float*)(tb + (par ^ 1) * BUFSZ + CUM_OFF + 4 * tid) = rc;
        asm volatile("s_waitcnt vmcnt(0)" ::: "memory");
        __syncthreads();
        if (kt + 1 >= nt) break;
    }
#pragma unroll
    for (int ct = 0; ct < NQ; ++ct) { att_finish_l(st[ct], 1.f);
        bf16* orow = OB + (size_t)(b * T + q0 + 16 * ct + n) * DM + 1024 + h * 64 + 4 * rg;
#pragma unroll
        for (int dt = 0; dt < 4; ++dt) { v2u w; w.x = cvt_pk(st[ct].ot[dt][0], st[ct].ot[dt][1]); w.y = cvt_pk(st[ct].ot[dt][2], st[ct].ot[dt][3]); *(v2u*)(orow + 16 * dt) = w; } }
}

constexpr int DIL4_OFF = 40960;
__device__ __forceinline__ void att_dil4_unit(LAS unsigned char* L, int b, int h, int u256, int tid, const bf16* QK, bf16* OB, const LAS float* tabs, const unsigned* KMX, const bf16* VDF) {
    asm volatile("" : "+v"(tid));
    const int lane = tid & 63, wave = __builtin_amdgcn_readfirstlane(tid >> 6), n = lane & 15, rg = lane >> 4;
    const LAS float* tab = tabs + (16 + h) * 32;
    bf16x8 qf[2][2]; int qpos[2];
#pragma unroll
    for (int ct = 0; ct < 2; ++ct) { qpos[ct] = 256 * u256 + 2 * wave + ct + 16 * n;
#pragma unroll
        for (int s = 0; s < 2; ++s) qf[ct][s] = ld16(QK + (size_t)(b * T + qpos[ct]) * NQK + C_QD + h * 64 + 32 * s + 8 * rg); }
    AttSt st[2]; att_init(st[0]); att_init(st[1]);
    const float kmx = sqrtf(__uint_as_float(KMX[b * 28 + 16 + h])) * 1.0001f;
    float nref[2];
#pragma unroll
    for (int ct = 0; ct < 2; ++ct) nref[ct] = -(q_norm(qf[ct]) * kmx + tabs[768 + 16 + h] + 1.585f);
    LAS float* lut = (LAS float*)(L + COOP_LUT_OFF);
    const bf16* Kg = QK + (size_t)b * T * NQK + C_KD + h * 64; const bf16* Vg = VDF + (size_t)(b * 512 + h * 64) * 16 * 512;
    int kl[2], vl[2]; size_t kgo[2], vgo[2];
#pragma unroll
    for (int j = 0; j < 2; ++j) { const int q = tid + 512 * j;
        { const int rho = q >> 8, s = (q >> 3) & 31, c = q & 7; kl[j] = 8192 * rho + 128 * s + 16 * (c ^ (((s >> 4) & 1) * 5 + ((s >> 1) & 1) * 2));
          kgo[j] = (size_t)(16 * (s & 7) + rho + 4 * (s >> 3)) * NQK + 8 * c; }
        { const int rho = q >> 8, d = (q >> 2) & 63, g = q & 3; vl[j] = 8192 * rho + 4096 + 64 * d + 16 * (g ^ (3 * ((d >> 3) & 1)));
          vgo[j] = ((size_t)d * 16 + (rho + 4 * g)) * 512; } }
    int kro[2][2], vro[4];
#pragma unroll
    for (int e = 0; e < 2; ++e) { const int rho_ = 8 * (n >> 2) + 4 * e + (n & 3); const int fk = ((rho_ >> 4) & 1) * 5 + ((rho_ >> 1) & 1) * 2;
#pragma unroll
        for (int s = 0; s < 2; ++s) kro[e][s] = 128 * rho_ + 16 * ((4 * s + rg) ^ fk); }
#pragma unroll
    for (int dt = 0; dt < 4; ++dt) { const int d = 16 * dt + n; vro[dt] = 4096 + 64 * d + 16 * (rg ^ (3 * ((d >> 3) & 1))); }
    const int kt0 = 2 * u256 - 4 < 0 ? 0 : 2 * u256 - 4, ktl = 2 * u256 + 1;
    LAS unsigned char* tb = L + DIL4_OFF;
    {   v4u rk[2], rv[2];
#pragma unroll
        for (int j = 0; j < 2; ++j) { rk[j] = *(const v4u*)(Kg + (size_t)(128 * kt0) * NQK + kgo[j]); rv[j] = *(const v4u*)(Vg + vgo[j] + 8 * kt0); }
        for (int i = tid; i < COOP_LUT_N; i += NTHR) { const int d = i - COOP_LUT_PAD; float v = -INFINITY;
            if (d >= 0) { const int mult = (d <= 128 ? 1 : 0) + (((d & 3) == 0 && d <= 512) ? 1 : 0) + (((d & 15) == 0 && d <= 512) ? 1 : 0); if (mult > 0) v = tab[t5b(d)] + (mult == 1 ? 0.f : (mult == 2 ? 1.f : 1.5849625007211562f)); }
            lut[i] = v; }
#pragma unroll
        for (int j = 0; j < 2; ++j) { *(LAS v4u*)(tb + kl[j]) = rk[j]; *(LAS v4u*)(tb + vl[j]) = rv[j]; } }
    __syncthreads();
    for (int kt = kt0, par = 0;; ++kt, par ^= 1) {
        const int nx = kt < ktl ? kt + 1 : kt;
        v4u rk[2], rv[2];
#pragma unroll
        for (int j = 0; j < 2; ++j) { rk[j] = *(const v4u*)(Kg + (size_t)(128 * nx) * NQK + kgo[j]); rv[j] = *(const v4u*)(Vg + vgo[j] + 8 * nx); }
        const LAS unsigned char* buf = tb + par * 32768;
        const int tile0 = 128 * kt;
        bool nd_all[2], nd_own[2];
#pragma unroll
        for (int ct = 0; ct < 2; ++ct) { const int qmin = 256 * u256 + 2 * wave + ct, dmin = qmin - tile0 - 127, dmax = qmin + 240 - tile0; nd_all[ct] = dmax >= 0 && dmin <= 128; nd_own[ct] = dmax >= 0 && dmin <= 512; }
#pragma unroll
        for (int rho = 0; rho < 4; ++rho) {
            const bool a0 = nd_all[0] || (nd_own[0] && ((2 * wave) & 3) == rho), a1 = nd_all[1] || (nd_own[1] && ((2 * wave + 1) & 3) == rho);
            if (!(a0 || a1)) continue;
            const LAS unsigned char* img = buf + 8192 * rho; KVFrag f;
#pragma unroll
            for (int e = 0; e < 2; ++e)
#pragma unroll
                for (int s = 0; s < 2; ++s) f.k[e][s] = *(const LAS bf16x8*)(img + kro[e][s]);
#pragma unroll
            for (int dt = 0; dt < 4; ++dt) f.v[dt] = *(const LAS bf16x8*)(img + vro[dt]);
#pragma unroll
            for (int ct = 0; ct < 2; ++ct) { if (!(ct ? a1 : a0)) continue;
                const f32x4 i0 = {nref[ct], nref[ct], nref[ct], nref[ct]}; f32x4 acc[2]; att_qk(acc, f, qf[ct], i0, i0);
                const LAS float* lp = lut + COOP_LUT_PAD + (qpos[ct] - tile0 - rho - 4 * rg);
#pragma unroll
                for (int i = 0; i < 8; ++i) { const float add = lp[-16 * i]; if (i < 4) acc[0][i] += add; else acc[1][i - 4] += add; }
                const bf16x8 p = att_softmax_refm(acc[0], acc[1]); att_pv_l(st[ct], f, p); } }
#pragma unroll
        for (int j = 0; j < 2; ++j) { *(LAS v4u*)(tb + (par ^ 1) * 32768 + kl[j]) = rk[j]; *(LAS v4u*)(tb + (par ^ 1) * 32768 + vl[j]) = rv[j]; }
        __syncthreads();
        if (kt >= ktl) break;
    }
    {
        const int Qf = 16 * u256;
#pragma unroll
        for (int ct = 0; ct < 2; ++ct) { const int r = 2 * wave + ct;
            const bf16* Kr = QK + (size_t)(b * T + r) * NQK + C_KD + h * 64;
            const bf16* Vr = VDF + ((size_t)(b * 512 + h * 64) * 16 + r) * 512;
            const float base = nref[ct]; const f32x4 i0 = {base, base, base, base};
            for (int sft = 0; sft < 4; ++sft) { const int k0f = Qf - 128 + 32 * sft; if (k0f + 31 < 0) continue;
                KVFrag f;
                { const int kr0 = k0f + 8 * (n >> 2) + (n & 3);
#pragma unroll
                  for (int e = 0; e < 2; ++e) { const int kr = kr0 + 4 * e < 0 ? 0 : kr0 + 4 * e;
#pragma unroll
                      for (int s2 = 0; s2 < 2; ++s2) f.k[e][s2] = ld16(Kr + (size_t)(16 * kr) * NQK + 32 * s2 + 8 * rg); }
                  const int kc = k0f + 8 * rg < 0 ? 0 : k0f + 8 * rg;
#pragma unroll
                  for (int dt = 0; dt < 4; ++dt) f.v[dt] = ld16(Vr + (size_t)(16 * dt + n) * (16 * 512) + kc); }
                f32x4 acc[2]; att_qk(acc, f, qf[ct], i0, i0);
#pragma unroll
                for (int i = 0; i < 8; ++i) { const int kf = k0f + 8 * rg + i, di = (Qf + n) - kf;
                    const float add = (kf >= 0 && di >= 33 && di <= 128) ? tab[t5b(16 * di)] : -INFINITY; if (i < 4) acc[0][i] += add; else acc[1][i - 4] += add; }
                const bf16x8 p = att_softmax_refm(acc[0], acc[1]); att_pv_l(st[ct], f, p); } }
    }
#pragma unroll
    for (int ct = 0; ct < 2; ++ct) { att_finish_l(st[ct], 1.f);
        bf16* orow = OB + (size_t)(b * T + qpos[ct]) * DM + 1536 + h * 64 + 4 * rg;
#pragma unroll
        for (int dt = 0; dt < 4; ++dt) { v2u w; w.x = cvt_pk(st[ct].ot[dt][0], st[ct].ot[dt][1]); w.y = cvt_pk(st[ct].ot[dt][2], st[ct].ot[dt][3]); *(v2u*)(orow + 16 * dt) = w; } }
}

__device__ __forceinline__ void moba_select_unit(int b, int h, int qb, int lane, const bf16* QK, const bf16* KMH, const bf16* KML, unsigned* SEL) {
    asm volatile("" : "+v"(lane));
    const int n = lane & 15, rg = lane >> 4, q0 = 32 * qb, own = qb >> 3;
    bf16x8 qf[2][2];
#pragma unroll
    for (int ct = 0; ct < 2; ++ct)
#pragma unroll
        for (int s = 0; s < 2; ++s) qf[ct][s] = ld16(QK + (size_t)(b * T + q0 + 16 * ct + n) * NQK + C_QB + h * 64 + 32 * s + 8 * rg);
    const bf16* kh = KMH + (size_t)(b * 8 + h) * 32 * 64; const bf16* kl = KML + (size_t)(b * 8 + h) * 32 * 64;
    bf16x8 gh[2][2], gl[2][2];
    const size_t ro = (size_t)(8 * (n >> 2) + (n & 3)) * 64 + 8 * rg;
#pragma unroll
    for (int e = 0; e < 2; ++e)
#pragma unroll
        for (int s = 0; s < 2; ++s) { gh[e][s] = ld16(kh + ro + (size_t)(4 * e) * 64 + 32 * s); gl[e][s] = ld16(kl + ro + (size_t)(4 * e) * 64 + 32 * s); }
#pragma unroll
    for (int ct = 0; ct < 2; ++ct) {
        f32x4 a0 = {0.f, 0.f, 0.f, 0.f}, a1 = {0.f, 0.f, 0.f, 0.f};
#pragma unroll
        for (int s = 0; s < 2; ++s) { a0 = MFMA16(gh[0][s], qf[ct][s], a0); a1 = MFMA16(gh[1][s], qf[ct][s], a1); a0 = MFMA16(gl[0][s], qf[ct][s], a0); a1 = MFMA16(gl[1][s], qf[ct][s], a1); }
        unsigned key[8]; unsigned selm = 0u;
#pragma unroll
        for (int i = 0; i < 8; ++i) { const int kb = 8 * rg + i; const float g = i < 4 ? a0[i] : a1[i - 4]; key[i] = kb < own ? ((ord_f32(g) & ~31u) | (unsigned)(31 - kb)) : 0u; }
#pragma unroll
        for (int r = 0; r < 3; ++r) { unsigned mx = key[0];
#pragma unroll
            for (int i = 1; i < 8; ++i) mx = key[i] > mx ? key[i] : mx;
            mx = rg_max_u32(mx);
            if (mx) selm |= 1u << (31 - (mx & 31u));
#pragma unroll
            for (int i = 0; i < 8; ++i) key[i] = key[i] == mx ? 0u : key[i]; }
        if (rg == 0) SEL[(size_t)(b * 8 + h) * T + q0 + 16 * ct + n] = selm; }
}
constexpr int MG_TILE_OFF = 40960, MG_Q_OFF = 4096, MG_SQ_OFF = 106496, MG_ROUND = 64;
static_assert(MG_SQ_OFF + (MG_ROUND * 64 + 64) * 4 <= RING_BYTES, "gather queue");
constexpr int MG_UNUSED_ = 0;
__device__ __forceinline__ void moba_gather_unit(LAS unsigned char* L, int b, int h, int j, int tid, const bf16* QK, const bf16* VT, const unsigned* SEL, bf16* PARTO, float* PARTL, const LAS float* tabs, const unsigned* KMX) {
    asm volatile("" : "+v"(tid));
    const int lane = tid & 63, wave = __builtin_amdgcn_readfirstlane(tid >> 6), n = lane & 15, rg = lane >> 4, bh = b * 8 + h;
    const LAS float* tab = tabs + (8 + h) * 32;
    LAS float* lut = (LAS float*)(L + COOP_LUT_OFF);
    LAS unsigned* sq = (LAS unsigned*)(L + MG_SQ_OFF); LAS unsigned* qc = (LAS unsigned*)(L + MG_Q_OFF);
    if (tid == 0) { qc[0] = 0u; qc[1] = 0u; }
    {
        const char* Kb = (const char*)(QK + (size_t)(b * T + 256 * j) * NQK + C_KB + h * 64); const char* Vb = (const char*)(VT + (size_t)(R_VB + h * 64) * M + (size_t)b * T + 256 * j);
        const bool isk = tid < 256; const int t2 = tid & 255; const int lrow = isk ? (t2 >> 3) : (t2 >> 2), lch = isk ? (t2 & 7) : (t2 & 3);
        const char* gb = isk ? Kb + (size_t)lrow * (NQK * 2) + 16 * lch : Vb + (size_t)lrow * ((size_t)M * 2) + 16 * lch; const size_t gs = isk ? (size_t)32 * NQK * 2 : (size_t)64;
        const int lofs = isk ? 128 * lrow + 16 * (lch ^ (((lrow >> 4) & 1) * 5 + ((lrow >> 1) & 1) * 2)) : 4096 + 64 * lrow + 16 * (lch ^ (3 * ((lrow >> 3) & 1)));
        v4u r[8];
#pragma unroll
        for (int t = 0; t < 8; ++t) r[t] = *(const v4u*)(gb + (size_t)t * gs);
        for (int i = tid; i < COOP_LUT_N; i += NTHR) { const int d = i - COOP_LUT_PAD; lut[i] = d >= 0 ? tab[t5b(d)] : -INFINITY; }
#pragma unroll
        for (int t = 0; t < 8; ++t) *(LAS v4u*)(L + MG_TILE_OFF + 8192 * t + lofs) = r[t]; }
    __syncthreads();
    int kro[2][2], vro[4];
#pragma unroll
    for (int e = 0; e < 2; ++e) { const int rho = 8 * (n >> 2) + 4 * e + (n & 3); const int fk = ((rho >> 4) & 1) * 5 + ((rho >> 1) & 1) * 2;
#pragma unroll
        for (int s = 0; s < 2; ++s) kro[e][s] = 128 * rho + 16 * ((4 * s + rg) ^ fk); }
#pragma unroll
    for (int dt = 0; dt < 4; ++dt) { const int d = 16 * dt + n; vro[dt] = 4096 + 64 * d + 16 * (rg ^ (3 * ((d >> 3) & 1))); }
    const float kmx = sqrtf(__uint_as_float(KMX[b * 28 + h])) * 1.0001f, tmx = tabs[768 + 8 + h];
    auto process = [&](const LAS unsigned* que, int nvalid) {
        bf16x8 qf[2][2]; float nref[2]; int qq[2], sl[2]; bool vld[2];
#pragma unroll
        for (int ct = 0; ct < 2; ++ct) { const int idx = 16 * ct + n; vld[ct] = idx < nvalid; const unsigned e = que[vld[ct] ? idx : 0]; qq[ct] = (int)(e & 0xffffu); sl[ct] = (int)(e >> 16);
#pragma unroll
            for (int s = 0; s < 2; ++s) qf[ct][s] = ld16(QK + (size_t)(b * T + qq[ct]) * NQK + C_QB + h * 64 + 32 * s + 8 * rg);
            nref[ct] = vld[ct] ? -(q_norm(qf[ct]) * kmx + tmx) : -INFINITY; }
        AttSt st[2]; att_init(st[0]); att_init(st[1]);
        for (int hh = 0; hh < 8; ++hh) { const LAS unsigned char* buf = L + MG_TILE_OFF + 8192 * hh; KVFrag f;
#pragma unroll
            for (int e = 0; e < 2; ++e)
#pragma unroll
                for (int s = 0; s < 2; ++s) f.k[e][s] = *(const LAS bf16x8*)(buf + kro[e][s]);
#pragma unroll
            for (int dt = 0; dt < 4; ++dt) f.v[dt] = *(const LAS bf16x8*)(buf + vro[dt]);
#pragma unroll
            for (int ct = 0; ct < 2; ++ct) { const f32x4 i0 = {nref[ct], nref[ct], nref[ct], nref[ct]}; f32x4 acc[2]; att_qk(acc, f, qf[ct], i0, i0);
                int dl = qq[ct] - (256 * j + 32 * hh + 8 * rg); dl = dl > 3000 ? 3000 : dl;
                const LAS float* lp = lut + COOP_LUT_PAD + dl - 7;
#pragma unroll
                for (int i = 0; i < 8; ++i) { const float add = lp[7 - i]; if (i < 4) acc[0][i] += add; else acc[1][i - 4] += add; }
                const bf16x8 p = att_softmax_refm(acc[0], acc[1]); att_pv_l(st[ct], f, p); } }
#pragma unroll
        for (int ct = 0; ct < 2; ++ct) { const float lt = st[ct].lv[0];
            if (vld[ct]) { const size_t pr = ((size_t)bh * T + qq[ct]) * 4 + sl[ct]; if (rg == 0) PARTL[pr] = lt;
#pragma unroll
                for (int dt = 0; dt < 4; ++dt) { v2u w; w.x = cvt_pk(st[ct].ot[dt][0], st[ct].ot[dt][1]); w.y = cvt_pk(st[ct].ot[dt][2], st[ct].ot[dt][3]); *(v2u*)(PARTO + pr * 64 + 16 * dt + 4 * rg) = w; } } } };
    const unsigned lowmask = (1u << j) - 1u;
    const int nchunks = 4 + (T - 256 * (j + 1)) / 64;
    for (int c0 = 0; c0 < nchunks; c0 += MG_ROUND) {
        const int c1 = c0 + MG_ROUND < nchunks ? c0 + MG_ROUND : nchunks;
        for (int c = c0 + wave; c < c1; c += NWAVES) {
            bool selq; unsigned entry;
            if (c < 4) { selq = true; entry = (unsigned)(256 * j + 64 * c + lane) | (3u << 16); }
            else { const int q = 256 * (j + 1) + 64 * (c - 4) + lane; const unsigned m = SEL[(size_t)bh * T + q]; selq = (m >> j) & 1u; entry = (unsigned)q | ((unsigned)__builtin_popcount(m & lowmask) << 16); }
            const unsigned long long bal = __ballot(selq); const int cw = (int)__builtin_popcountll(bal);
            if (cw) { unsigned base = 0u; if (lane == 0) base = __hip_atomic_fetch_add(qc, (unsigned)cw, __ATOMIC_RELAXED, __HIP_MEMORY_SCOPE_WORKGROUP);
                base = __builtin_amdgcn_readfirstlane(base);
                if (selq) { const int pos = (int)__builtin_amdgcn_mbcnt_hi((unsigned)(bal >> 32), __builtin_amdgcn_mbcnt_lo((unsigned)bal, 0u)); sq[base + pos] = entry; } } }
        __syncthreads();
        const int total = (int)qc[0], ngroups = (total + 31) >> 5;
        for (;;) { unsigned g = 0u; if (lane == 0) g = __hip_atomic_fetch_add(qc + 1, 1u, __ATOMIC_RELAXED, __HIP_MEMORY_SCOPE_WORKGROUP);
            g = __builtin_amdgcn_readfirstlane(g); if ((int)g >= ngroups) break;
            process(sq + 32 * g, total - 32 * (int)g < 32 ? total - 32 * (int)g : 32); }
        __syncthreads();
        if (c1 < nchunks) { if (tid == 0) { qc[0] = 0u; qc[1] = 0u; } __syncthreads(); }
    }
    __syncthreads();
}

__device__ __forceinline__ void att_build_tabs(LAS float* tabs, const float* relb, int tid) {
    for (int i = tid; i < 24 * 32; i += NTHR) { const int h = i >> 5, bk = i & 31; tabs[i] = relb[bk * 24 + h] * LOG2E; }
    if (tid < 24) { float mx = -INFINITY; for (int bk = 0; bk < 32; ++bk) mx = fmaxf(mx, relb[bk * 24 + tid] * LOG2E); tabs[768 + tid] = mx; }
}
constexpr int ATT_TAB_OFF = 0, ATT_WL_OFF = 24576;

template <int MIX> __global__ void __launch_bounds__(NTHR, 2) k_att_dense(Args args) {
    extern __shared__ __attribute__((aligned(16))) unsigned char lds[];
    LAS unsigned char* L = (LAS unsigned char*)lds;
    const int tid = threadIdx.x, lane = tid & 63, wave = __builtin_amdgcn_readfirstlane(tid >> 6);
    const int gw = blockIdx.x * NWAVES + wave, NGW = gridDim.x * NWAVES;
    unsigned char* ws = args.ws;
    const bf16* QK = (const bf16*)(ws + WS_QK); const bf16* VT = (const bf16*)(ws + WS_VT); bf16* OB = (bf16*)(ws + WS_O);
    const float* CUM = (const float*)(ws + WS_CUM); const bf16* KMH = (const bf16*)(ws + WS_KMH); const bf16* KML = (const bf16*)(ws + WS_KML);
    const unsigned* KMX = (const unsigned*)(ws + WS_CTL) + CW_KMAX;
    LAS float* tabs = (LAS float*)(L + ATT_TAB_OFF);
    att_build_tabs(tabs, args.in[15], tid);
    __syncthreads();
    int k = 0;
    for (int u = gw; u < BATCH * 8 * 256; u += NGW, ++k) { const int bh = u >> 8, qi = u & 255, qb = (k & 1) ? 255 - qi : qi;
        att_dense_unit<MIX>(bh >> 3, bh & 7, qb, lane, QK, VT, CUM, KMH, KML, OB, tabs, KMX); }
}
__global__ void __launch_bounds__(NTHR, 2) k_att_nsa(Args args) {
    extern __shared__ __attribute__((aligned(16))) unsigned char lds[];
    LAS unsigned char* L = (LAS unsigned char*)lds;
    const int tid = threadIdx.x, lane = tid & 63, wave = __builtin_amdgcn_readfirstlane(tid >> 6);
    const int gw = blockIdx.x * NWAVES + wave, NGW = gridDim.x * NWAVES;
    unsigned char* ws = args.ws;
    const bf16* QK = (const bf16*)(ws + WS_QK); const bf16* VT = (const bf16*)(ws + WS_VT); bf16* OB = (bf16*)(ws + WS_O);
    const bf16* KC = (const bf16*)(ws + WS_KC); const bf16* VCT = (const bf16*)(ws + WS_VCT);
    const unsigned* KMX = (const unsigned*)(ws + WS_CTL) + CW_KMAX;
    LAS float* tabs = (LAS float*)(L + ATT_TAB_OFF);
    att_build_tabs(tabs, args.in[15], tid);
    __syncthreads();
    LAS float* wl = (LAS float*)(L + ATT_WL_OFF) + wave * NSA_WLDS;
    for (int u = gw; u < BATCH * 2 * (T / 8); u += NGW) { const int bg = u / (T / 8), t0 = (u % (T / 8)) * 8;
        att_nsa_unit(bg >> 1, bg & 1, t0, lane, QK, VT, KC, VCT, OB, tabs, wl, KMX); }
}

typedef __attribute__((address_space(4))) const Args CArgs;
constexpr int I_QK = 32 * (NQK / 32), I_V = 32 * (NV / 32), I_OUT = 32 * (DM / 32), I_UP = 32 * (DFF / 32), I_DOWN = (DFF / 64) * (DM / 32);
constexpr int I_LAYER = I_QK + I_V + I_OUT + I_UP + I_DOWN;
constexpr int I_LATE = (I_LAYER - I_QK - I_V) + (DEPTH - 1) * I_LAYER;
template <bool DEEP>
__device__ __forceinline__ void conv_big_item(CArgs* ap, unsigned char* ws, int l, int r, LAS float* scr, int lane) {
    unsigned char* wl = ws + WS_W + (size_t)l * W_LAYER;
    if (r < I_QK) { transpose_item<1, DEEP>(ap->in[1] + (size_t)l * DM * PW, DM, PW, (bf16*)(wl + WO_QK), NQK, scr, r, lane, ap->in[3] + (size_t)l * DM); return; } r -= I_QK;
    if (r < I_V) { transpose_item<2, DEEP>(ap->in[1] + (size_t)l * DM * PW, DM, PW, (bf16*)(wl + WO_V), NV, scr, r, lane, ap->in[3] + (size_t)l * DM); return; } r -= I_V;
    if (r < I_OUT) { transpose_item<0, DEEP>(ap->in[2] + (size_t)l * DM * DM, DM, DM, (bf16*)(wl + WO_OUT), DM, scr, r, lane); return; } r -= I_OUT;
    if (r < I_UP) { transpose_item<0, DEEP>(ap->in[7] + (size_t)l * DM * DFF, DM, DFF, (bf16*)(wl + WO_UP), DFF, scr, r, lane, ap->in[5] + (size_t)l * DM); return; } r -= I_UP;
    transpose_item<0, DEEP>(ap->in[8] + (size_t)l * DFF * DM, DFF, DM, (bf16*)(wl + WO_DOWN), DM, scr, r, lane);
}
__global__ void __launch_bounds__(NTHR, 2) fwd(Args args) {
    extern __shared__ __attribute__((aligned(16))) unsigned char lds[];
    LAS unsigned char* L = (LAS unsigned char*)lds;
    volatile LAS unsigned* MISC = (volatile LAS unsigned*)(L + MISC_OFF);
    const int G = gridDim.x, NGW = G * NWAVES;
#define PHASE_IDS CArgs* ap = (CArgs*)__builtin_amdgcn_kernarg_segment_ptr(); asm volatile("" : "+s"(ap)); unsigned char* ws = ap->ws; (void)ws; int tid = tid_base + (int)__builtin_amdgcn_mbcnt_hi(~0u, __builtin_amdgcn_mbcnt_lo(~0u, 0u)); asm volatile("" : "+v"(tid)); const int lane = tid & 63, wave = __builtin_amdgcn_readfirstlane(tid >> 6), gw = blockIdx.x * NWAVES + wave; (void)lane; (void)gw;
    unsigned* ctl = (unsigned*)(args.ws + WS_CTL);
    for (int u = threadIdx.x; u < (LDS_BYTES - RING_BYTES) / 4; u += NTHR) ((LAS unsigned*)(L + RING_BYTES))[u] = 0u;
    __syncthreads();
    const int lane_hw = (int)__builtin_amdgcn_mbcnt_hi(~0u, __builtin_amdgcn_mbcnt_lo(~0u, 0u));
    const unsigned simd = (unsigned)__builtin_amdgcn_s_getreg((1 << 11) | (4 << 6) | 4) & 3u;
    int tkt = 0, tks = 0;
    if (lane_hw == 0) { tkt = (int)__hip_atomic_fetch_add((LAS unsigned*)(L + MISC_OFF) + 12, 1u, __ATOMIC_RELAXED, __HIP_MEMORY_SCOPE_WORKGROUP);
                        tks = (int)__hip_atomic_fetch_add((LAS unsigned*)(L + MISC_OFF) + 16 + simd, 1u, __ATOMIC_RELAXED, __HIP_MEMORY_SCOPE_WORKGROUP); }
    __syncthreads();
    const bool two_each = MISC[16] == 2u && MISC[17] == 2u && MISC[18] == 2u && MISC[19] == 2u;
    const int slot = (int)(((simd & 1u) << 1) | (simd >> 1));
    const int tid_base = 64 * (two_each ? slot + 4 * __builtin_amdgcn_readfirstlane(tks) : __builtin_amdgcn_readfirstlane(tkt));
    XcdBarrier bar = xcd_barrier_post(ctl + CW_BAR, MISC + 8, (tid_base == 0 && lane_hw == 0) ? 1 : 0);
    const int lo = args.ph_lo, hi = args.ph_hi;
#define IN(k) (lo <= (k) && (k) < hi)
#define SEAM(k) do { if (IN(k) && IN((k) + 1)) xcd_barrier(bar); } while (0)
#define PTRS bf16* XN = (bf16*)(ws + WS_XN); bf16* Y = (bf16*)(ws + WS_Y); bf16* QK = (bf16*)(ws + WS_QK); bf16* VT = (bf16*)(ws + WS_VT); bf16* OB = (bf16*)(ws + WS_O); bf16* H = (bf16*)(ws + WS_H); \
    bf16* KCb = (bf16*)(ws + WS_KC); float* CUM = (float*)(ws + WS_CUM); (void)XN; (void)Y; (void)QK; (void)VT; (void)OB; (void)H; (void)KCb; (void)CUM;
    if (IN(0)) {
        PHASE_IDS PTRS
        LAS float* scr = (LAS float*)(L + wave * 16384);
        for (int rep = 0; rep < P0_REP; ++rep) {
        for (int it = gw; it < I_QK + I_V; it += NGW) conv_big_item<false>(ap, ws, 0, it, scr, lane);
        for (int it = gw; it < DEPTH * 2 * (256 + 8); it += NGW) { const int l = it / (2 * 264), r = it % (2 * 264), which = r / 264, q = r % 264;
            unsigned char* wl = ws + WS_W + (size_t)l * W_LAYER; unsigned char* sw = ws + WS_SW + (size_t)l * SW_LAYER;
            if (q < 256) transpose_item<0>(ap->in[which ? 12 : 10] + (size_t)l * 2048 * 256, 2048, 256, (bf16*)(wl + (which ? WO_W1V : WO_W1K)), 256, scr, q, lane);
            else transpose_item<0>(ap->in[which ? 13 : 11] + (size_t)l * 256 * 64, 256, 64, (bf16*)(sw + (which ? SW_W2V : SW_W2K)), 64, scr, q - 256, lane); }
        for (int it = gw; it < DEPTH * 2 * 256; it += NGW) { const int l = it >> 9, which = (it >> 8) & 1, nn = it & 255;
            const float* pe = ap->in[9] + (size_t)l * 2048; const float* w1 = ap->in[which ? 12 : 10] + (size_t)l * 2048 * 256 + nn; float a = 0.f;
            for (int k = lane; k < 2048; k += 64) a += pe[k] * w1[(size_t)k * 256];
            a = wave_sum(a); if (lane == 0) ((float*)(ws + WS_SW + (size_t)l * SW_LAYER + SW_HB))[which * 256 + nn] = a; }
        for (int m = gw; m < M; m += NGW) norm_pre_row(ap->in[0] + (size_t)m * DM, XN + (size_t)m * DM, (float*)(ws + WS_RSTD) + m, lane);
        for (int i = gw * 64 + lane; i < DEPTH * 2 * 2 * M; i += NGW * 64) ((unsigned long long*)(ws + WS_SSQ))[i] = 0ull;
        }
    }
    SEAM(0);

    auto layer = [&](auto LC) __attribute__((always_inline)) -> void {
        constexpr int l = decltype(LC)::value;
        const int pb = 1 + 7 * l;
        if (IN(pb + 0)) {
            PHASE_IDS PTRS (void)tid;
            unsigned char* wl = ws + WS_W + (size_t)l * W_LAYER;
            { pg8::Gemm g{XN, (const bf16*)(wl + WO_QK), M, NQK, DM}; pg8::StaticOrder S; S.init(M, NQK, G, (int)blockIdx.x);
              const void* rsp = l == 0 ? (const void*)(ws + WS_RSTD) : (const void*)((const unsigned long long*)(ws + WS_SSQ) + (size_t)(((l - 1) * 2 + 1) * 2 + 1) * M);
              pg8::EpiBf16<0, 1, (l > 0), true> E{QK, NQK, rsp, (unsigned*)(ws + WS_CTL) + CW_K2 + l * 224}; pg8::gemm_phase<pg8::EpiBf16<0, 1, (l > 0), true>, pg8::StaticOrder, false, true>(L, g, S, E, tid); }
            { pg8::Gemm g{(const bf16*)(wl + WO_V), XN, NV, M, DM}; pg8::StaticOrder S; S.init(NV, M, G, (int)blockIdx.x);
              const void* rsp = l == 0 ? (const void*)(ws + WS_RSTD) : (const void*)((const unsigned long long*)(ws + WS_SSQ) + (size_t)(((l - 1) * 2 + 1) * 2 + 1) * M);
              pg8::EpiBf16<0, 2, (l > 0)> E{VT, M, rsp}; pg8::gemm_phase<pg8::EpiBf16<0, 2, (l > 0)>, pg8::StaticOrder, false, true>(L, g, S, E, tid); }
        }
        SEAM(pb + 0);
        if (IN(pb + 1)) {
            PHASE_IDS PTRS
            unsigned char* wl = ws + WS_W + (size_t)l * W_LAYER;
            const unsigned char* sw = ws + WS_SW + (size_t)l * SW_LAYER;
            for (int rep = 0; rep < PRE_REP; ++rep) {
            for (int u = blockIdx.x; u < 256; u += G) { const int which = u >> 7, bg = (u >> 4) & 7, cb = u & 15;
                compress_unit(L, which, bg, cb, QK, (const bf16*)(wl + (which ? WO_W1V : WO_W1K)), (const bf16*)(sw + (which ? SW_W2V : SW_W2K)), (const float*)(sw + SW_HB) + which * 256, KCb, (bf16*)(ws + WS_VCT), wave, lane); }
            for (int u = gw; u < BATCH * 8 * 32; u += NGW) { const int bh = u >> 5, kb = u & 31, b = bh >> 3, h = bh & 7;
                const int rsub = lane >> 3, c8 = lane & 7; const bf16* p = QK + (size_t)(b * T + kb * 256 + rsub) * NQK + C_KB + h * 64 + 8 * c8;
                float s8[8] = {0.f, 0.f, 0.f, 0.f, 0.f, 0.f, 0.f, 0.f};
#pragma unroll 8
                for (int it = 0; it < 32; ++it) { const v4u w = *(const v4u*)(p + (size_t)(8 * it) * NQK);
                    s8[0] += bf_lo(w.x); s8[1] += bf_hi(w.x); s8[2] += bf_lo(w.y); s8[3] += bf_hi(w.y); s8[4] += bf_lo(w.z); s8[5] += bf_hi(w.z); s8[6] += bf_lo(w.w); s8[7] += bf_hi(w.w); }
                unsigned hb[8], lb[8];
#pragma unroll
                for (int k = 0; k < 8; ++k) { float v = s8[k]; v += __shfl_xor(v, 8); v += __shfl_xor(v, 16); v += __shfl_xor(v, 32); const float km = v * (1.f / 256.f); hb[k] = f2bf(km); lb[k] = f2bf(km - bf_lo(hb[k])); }
                if (rsub == 0) { v4u oh, ol; oh.x = hb[0] | (hb[1] << 16); oh.y = hb[2] | (hb[3] << 16); oh.z = hb[4] | (hb[5] << 16); oh.w = hb[6] | (hb[7] << 16);
                    ol.x = lb[0] | (lb[1] << 16); ol.y = lb[2] | (lb[3] << 16); ol.z = lb[4] | (lb[5] << 16); ol.w = lb[6] | (lb[7] << 16);
                    *(v4u*)((bf16*)(ws + WS_KMH) + (size_t)u * 64 + 8 * c8) = oh; *(v4u*)((bf16*)(ws + WS_KML) + (size_t)u * 64 + 8 * c8) = ol; } }
            if (blockIdx.x == 0 && tid < BATCH * 28) {
                const unsigned* k2 = (const unsigned*)(ws + WS_CTL) + CW_K2 + l * 224;
                ((unsigned*)(ws + WS_CTL))[CW_KMAX + l * 112 + tid] = __float_as_uint((__uint_as_float(k2[2 * tid]) + __uint_as_float(k2[2 * tid + 1])) * 1.01f); }
            {
                bf16* VDFw = (bf16*)(ws + WS_VDF);
                for (int it = gw * 64 + lane; it < BATCH * 512 * 64; it += NGW * 64) { const int k8 = it & 63, row = (it >> 6) & 511, b2 = it >> 15;
                    const v4u* src = (const v4u*)(VT + (size_t)(R_VD + row) * M + (size_t)b2 * T + 128 * k8);
                    bf16* dst = VDFw + ((size_t)(b2 * 512 + row) * 16) * 512 + 8 * k8;
#pragma unroll
                    for (int ph = 0; ph < 2; ++ph) { v4u w[8];
#pragma unroll
                        for (int kk = 0; kk < 8; ++kk) w[kk] = src[2 * kk + ph];
#pragma unroll
                        for (int j = 0; j < 8; ++j) { unsigned e[8];
#pragma unroll
                            for (int kk = 0; kk < 8; ++kk) { const unsigned d = (j >> 1) == 0 ? w[kk].x : ((j >> 1) == 1 ? w[kk].y : ((j >> 1) == 2 ? w[kk].z : w[kk].w)); e[kk] = (j & 1) ? (d >> 16) : (d & 0xffffu); }
                            v4u o; o.x = e[0] | (e[1] << 16); o.y = e[2] | (e[3] << 16); o.z = e[4] | (e[5] << 16); o.w = e[6] | (e[7] << 16);
                            *(v4u*)(dst + (size_t)(8 * ph + j) * 512) = o; } } } }
            for (int u = blockIdx.x; u < BATCH * 8; u += G) { const int b = u >> 3, h = u & 7;
                cumsum_unit(L, VT + (size_t)(R_FC + h) * M + (size_t)b * T, ap->in[14][l * 8 + h], CUM + (size_t)u * T, tid); }
            }
        }
        SEAM(pb + 1);
        if (IN(pb + 2)) {
            PHASE_IDS PTRS
            if constexpr (l == 0) {
                if ((((int)blockIdx.x >> 3) & 3) == 0) {
                    LAS float* scr = (LAS float*)(L + 8192 + wave * 8704);
                    for (int c = ((((int)blockIdx.x >> 5) << 3) | ((int)blockIdx.x & 7)) * NWAVES + wave; c < I_LATE; c += (G >> 2) * NWAVES) {
                        if (c < I_LAYER - I_QK - I_V) conv_big_item<true>(ap, ws, 0, I_QK + I_V + c, scr, lane); else conv_big_item<true>(ap, ws, 1, c - (I_LAYER - I_QK - I_V), scr, lane); }
                    __syncthreads(); } }
            LAS float* tabs = (LAS float*)(L + ATT_TAB_OFF);
            att_build_tabs(tabs, ap->in[15], tid);
            __syncthreads();
            const bf16* KMH = (const bf16*)(ws + WS_KMH); const bf16* KML = (const bf16*)(ws + WS_KML); const bf16* VCT = (const bf16*)(ws + WS_VCT);
            const unsigned* KMX = (const unsigned*)(ws + WS_CTL) + CW_KMAX + l * 112;
            const int vcu = (G % 8 == 0) ? ((int)blockIdx.x % 8) * (G / 8) + (int)blockIdx.x / 8 : (int)blockIdx.x;
            {
                constexpr int Q_SEL = BATCH * 8 * 8, Q_NSA = Q_SEL + BATCH * 2 * (T / 64), Q_FOX = Q_NSA + BATCH * 8 * (T / (128 * FOX_NQ)), Q_END = Q_FOX + 32 * BATCH * 8;
                unsigned* qctr = (unsigned*)(ws + WS_CTL) + CW_Q + 2 * l; unsigned* seldone = qctr + 1; int lastg = -1; bool sel_ready = false, sel_rel = false;
                for (;;) {
                    __syncthreads();
                    if (tid == 0) MISC[20] = __hip_atomic_fetch_add(qctr, 1u, __ATOMIC_RELAXED, __HIP_MEMORY_SCOPE_AGENT);
                    __syncthreads();
                    const int i = (int)MISC[20];
                    if (!sel_rel && i >= Q_SEL) {
                        if (tid == 0) { __builtin_amdgcn_fence(__ATOMIC_RELEASE, "agent"); asm volatile("s_waitcnt vmcnt(0)" ::: "memory"); (void)__hip_atomic_fetch_add(seldone, 1u, __ATOMIC_RELAXED, __HIP_MEMORY_SCOPE_AGENT); }
                        sel_rel = true; }
                    if (i >= Q_END) break;
                    if (i < Q_SEL) { for (int k4 = 0; k4 < 4; ++k4) { const int u = (4 * i + k4) * NWAVES + wave, bh = u >> 8, qb = u & 255; moba_select_unit(bh >> 3, bh & 7, qb, lane, QK, KMH, KML, (unsigned*)(ws + WS_SEL)); }
                        asm volatile("s_waitcnt vmcnt(0)" ::: "memory"); }
                    else if (i < Q_NSA) { const int i1 = i - Q_SEL, bg = i1 & 7, t0 = (T / 64 - 1 - (i1 >> 3)) * 64;
                        if ((bg & 1) != lastg) { nsa_build_lut(L, tabs, bg & 1, tid); lastg = bg & 1; __syncthreads(); }
                        att_nsa_coop_unit(L, bg >> 1, bg & 1, t0, tid, QK, VT, KCb, VCT, OB, tabs, KMX, (unsigned*)(ws + WS_NMSK)); }
                    else if (i < Q_FOX) { const int i2 = i - Q_NSA, bh = i2 & 31, uq = T / (128 * FOX_NQ) - 1 - (i2 >> 5); lastg = -1;
                        att_fox_unit<FOX_NB, FOX_NQ>(L, bh >> 3, bh & 7, uq, tid, QK, VT, CUM, OB, KMX); }
                    else { const int i3 = i - Q_FOX, j = i3 / (BATCH * 8), bh = i3 % (BATCH * 8); lastg = -1;
                        if (!sel_ready) {
                            if (tid == 0) { XB_SPIN(xb_ld(seldone) < (unsigned)G, (unsigned*)(ws + WS_CTL) + CW_BAR); __builtin_amdgcn_fence(__ATOMIC_ACQUIRE, "agent"); asm volatile("s_waitcnt vmcnt(0)" ::: "memory"); }
                            __syncthreads(); sel_ready = true; }
                        moba_gather_unit(L, bh >> 3, bh & 7, j, tid, QK, VT, (const unsigned*)(ws + WS_SEL), (bf16*)(ws + WS_PARTO), (float*)(ws + WS_PARTL), tabs, KMX); } } }
            __syncthreads();
        }
        SEAM(pb + 2);
        if (IN(pb + 3)) {
            PHASE_IDS PTRS
            {   LAS float* tabs = (LAS float*)(L + ATT_TAB_OFF);
                att_build_tabs(tabs, ap->in[15], tid);
                __syncthreads();
                const bf16* KMH = (const bf16*)(ws + WS_KMH); const bf16* KML = (const bf16*)(ws + WS_KML);
                const unsigned* KMX = (const unsigned*)(ws + WS_CTL) + CW_KMAX + l * 112;
                constexpr int Q2_SEL = BATCH * 2 * (T / 128), Q2_D = Q2_SEL + BATCH * 8 * 32, Q2_END = Q2_D + BATCH * 8 * (T / 32) / (4 * NWAVES);
                unsigned* qctr = (unsigned*)(ws + WS_CTL) + CW_Q + 2 * l + 8; int lastg = -1;
                for (;;) {
                    __syncthreads();
                    if (tid == 0) MISC[20] = __hip_atomic_fetch_add(qctr, 1u, __ATOMIC_RELAXED, __HIP_MEMORY_SCOPE_AGENT);
                    __syncthreads();
                    const int i = (int)MISC[20];
                    if (i >= Q2_END) break;
                    if (i < Q2_SEL) { const int bg = i & 7, t0 = (T / 128 - 1 - (i >> 3)) * 128;
                        if ((bg & 1) != lastg) { nsa_build_lut(L, tabs, bg & 1, tid); lastg = bg & 1; __syncthreads(); }
                        nsa_sel128_unit(L, bg >> 1, bg & 1, t0, tid, QK, VT, OB, tabs, KMX, (const unsigned*)(ws + WS_NMSK)); }
                    else if (i < Q2_D) { const int i4 = i - Q2_SEL, bh = i4 >> 5, uq = i4 & 31; lastg = -1;
                        att_dil4_unit(L, bh >> 3, bh & 7, uq, tid, QK, OB, tabs, KMX, (const bf16*)(ws + WS_VDF)); }
                    else { const int c0 = (i - Q2_D) * 4 * NWAVES + wave;
            const bf16* PO = (const bf16*)(ws + WS_PARTO); const float* PL = (const float*)(ws + WS_PARTL);
            const int n = lane & 15, rg = lane >> 4;
            for (int u = c0; u < c0 + 4 * NWAVES; u += NWAVES) { const int bh = u >> 8, qb = u & 255, own = qb >> 3, cnt = own < 3 ? own : 3;
#pragma unroll
                for (int ct = 0; ct < 2; ++ct) { const int q = 32 * qb + 16 * ct + n; const size_t pr = ((size_t)bh * T + q) * 4;
                    float pl[4]; v2u pv[4][4];
#pragma unroll
                    for (int sl = 0; sl < 4; ++sl) { const size_t ps = pr + ((sl == 3 || sl < cnt) ? sl : 3); pl[sl] = PL[ps];
#pragma unroll
                        for (int dt = 0; dt < 4; ++dt) pv[sl][dt] = *(const v2u*)(PO + ps * 64 + 16 * dt + 4 * rg); }
                    float lt = 0.f; f32x4 o[4] = {{0.f, 0.f, 0.f, 0.f}, {0.f, 0.f, 0.f, 0.f}, {0.f, 0.f, 0.f, 0.f}, {0.f, 0.f, 0.f, 0.f}};
#pragma unroll
                    for (int sl = 0; sl < 4; ++sl) if (sl == 3 || sl < cnt) { lt += pl[sl];
#pragma unroll
                        for (int dt = 0; dt < 4; ++dt) o[dt] = o[dt] + (f32x4){bf_lo(pv[sl][dt].x), bf_hi(pv[sl][dt].x), bf_lo(pv[sl][dt].y), bf_hi(pv[sl][dt].y)}; }
                    const float sc = lt > 0.f ? 1.f / lt : 0.f;
                    bf16* orow = OB + (size_t)((bh >> 3) * T + q) * DM + 512 + (bh & 7) * 64 + 4 * rg;
#pragma unroll
                    for (int dt = 0; dt < 4; ++dt) { v2u w; w.x = cvt_pk(o[dt][0] * sc, o[dt][1] * sc); w.y = cvt_pk(o[dt][2] * sc, o[dt][3] * sc); *(v2u*)(orow + 16 * dt) = w; } } } } }
                __syncthreads(); }
        }
        SEAM(pb + 3);
        if (IN(pb + 4)) {
            PHASE_IDS PTRS (void)tid;
            unsigned char* wl = ws + WS_W + (size_t)l * W_LAYER;
            pg8::Gemm g{OB, (const bf16*)(wl + WO_OUT), M, DM, DM}; pg8::PanelOrder S; S.init((int)blockIdx.x);
            unsigned long long* ssq = (unsigned long long*)(ws + WS_SSQ) + (size_t)((l * 2 + 0) * 2) * M;
            pg8::EpiNormRes<false> E{XN, ap->in[4] + (size_t)l * DM, ssq, ssq + M, (unsigned*)(ws + WS_CTL) + CW_NC + (l * 2 + 0) * 256, nullptr};
            pg8::gemm_phase<pg8::EpiNormRes<false>, pg8::PanelOrder, true, true>(L, g, S, E, tid);
        }
        SEAM(pb + 4);
        if (IN(pb + 5)) {
            PHASE_IDS PTRS (void)tid;
            unsigned char* wl = ws + WS_W + (size_t)l * W_LAYER;
            pg8::Gemm g{XN, (const bf16*)(wl + WO_UP), M, DFF, DM}; pg8::StaticOrder S; S.init(M, DFF, G, (int)blockIdx.x);
            pg8::EpiBf16<2, 1, true> E{H, DFF, (const void*)((const unsigned long long*)(ws + WS_SSQ) + (size_t)((l * 2 + 0) * 2 + 1) * M)}; pg8::gemm_phase<pg8::EpiBf16<2, 1, true>, pg8::StaticOrder, false, true>(L, g, S, E, tid);
        }
        SEAM(pb + 5);
        if (IN(pb + 6)) {
            PHASE_IDS PTRS (void)tid;
            unsigned char* wl = ws + WS_W + (size_t)l * W_LAYER;
            pg8::Gemm g{H, (const bf16*)(wl + WO_DOWN), M, DM, DFF}; pg8::PanelOrder S; S.init((int)blockIdx.x);
            unsigned long long* ssq = (unsigned long long*)(ws + WS_SSQ) + (size_t)((l * 2 + 1) * 2) * M;
            pg8::EpiNormRes<(l + 1 == DEPTH)> E{XN, ap->in[6] + (size_t)l * DM, ssq, ssq + M, (unsigned*)(ws + WS_CTL) + CW_NC + (l * 2 + 1) * 256, ap->out};
            pg8::gemm_phase<pg8::EpiNormRes<(l + 1 == DEPTH)>, pg8::PanelOrder, true, true>(L, g, S, E, tid);
        }
        SEAM(pb + 6);
    };
    layer(std::integral_constant<int, 0>{});
    layer(std::integral_constant<int, 1>{});
    static_assert(DEPTH == 2, "two layer instantiations");
#undef IN
#undef SEAM
}

constexpr int N_PHASES = 1 + 7 * DEPTH;
extern "C" void kernel_launch(void* const* d_in, const int* in_sizes, int n_in, void* d_out, int out_size, void* d_ws, size_t ws_size, hipStream_t stream) {
    static int grid = 0;
    if (grid == 0) {
        if (n_in != 16 || in_sizes[0] != M * DM || out_size != M * DM || ws_size < WS_END + 40 * MiB) { fprintf(stderr, "kernel_launch: unexpected shapes / workspace (n_in %d, ws %zu, need %zu)\n", n_in, ws_size, (size_t)WS_END); grid = -1; return; }
        int dev = 0, cus = 0;
        if (hipGetDevice(&dev) != hipSuccess || hipDeviceGetAttribute(&cus, hipDeviceAttributeMultiprocessorCount, dev) != hipSuccess) { grid = -1; return; }
        (void)hipFuncSetAttribute((const void*)k_att_dense<0>, hipFuncAttributeMaxDynamicSharedMemorySize, LDS_BYTES); (void)hipFuncSetAttribute((const void*)k_att_dense<1>, hipFuncAttributeMaxDynamicSharedMemorySize, LDS_BYTES);
        (void)hipFuncSetAttribute((const void*)k_att_dense<2>, hipFuncAttributeMaxDynamicSharedMemorySize, LDS_BYTES); (void)hipFuncSetAttribute((const void*)k_att_nsa, hipFuncAttributeMaxDynamicSharedMemorySize, LDS_BYTES);
        if (hipFuncSetAttribute((const void*)fwd, hipFuncAttributeMaxDynamicSharedMemorySize, LDS_BYTES) != hipSuccess) { fprintf(stderr, "kernel_launch: hipFuncSetAttribute failed\n"); grid = -1; return; }
        int per_cu = 0;
        if (hipOccupancyMaxActiveBlocksPerMultiprocessor(&per_cu, (const void*)fwd, NTHR, LDS_BYTES) != hipSuccess || per_cu < 1) fprintf(stderr, "kernel_launch: occupancy query says %d\n", per_cu);
        (void)hipGetLastError();
        if (cus != 256) { fprintf(stderr, "kernel_launch: the fused residual epilogues are laid out for 256 CUs (found %d)\n", cus); grid = -1; return; }
        grid = cus;
    }
    if (grid < 0) return;
    (void)hipMemsetAsync((char*)d_ws + WS_CTL, 0, CTL_ZERO_BYTES, stream);
    Args a{};
    for (int i = 0; i < 16; ++i) a.in[i] = (const float*)d_in[i];
    a.out = (float*)d_out; a.ws = (unsigned char*)d_ws;
#if N_LAUNCH_PER_PHASE
    for (int p = 0; p < N_PHASES; ++p) {
        const int l = (p - 1) / 8, j = (p - 1) % 8;
#if defined(NAIVE_ATT) && !defined(FUSED_ATT)
        if (p >= 1 && j == 1) { hipLaunchKernelGGL(k_naive_vn, dim3(4096), dim3(256), 0, stream, a); hipLaunchKernelGGL(k_naive_pre, dim3(2048), dim3(256), 0, stream, a, l); continue; }
#if defined(FAST_ATT) && !defined(FUSED_ATT)
        if (p >= 1 && j == 2) { hipLaunchKernelGGL(k_att_dense<0>, dim3(grid), dim3(NTHR), LDS_BYTES, stream, a); hipLaunchKernelGGL(k_att_dense<1>, dim3(grid), dim3(NTHR), LDS_BYTES, stream, a); hipLaunchKernelGGL(k_att_dense<2>, dim3(grid), dim3(NTHR), LDS_BYTES, stream, a); hipLaunchKernelGGL(k_att_nsa, dim3(grid), dim3(NTHR), LDS_BYTES, stream, a); continue; }
#endif
        if (p >= 1 && j == 2) { hipLaunchKernelGGL(k_naive_bcd<0>, dim3(4096), dim3(256), 0, stream, a, l); hipLaunchKernelGGL(k_naive_bcd<1>, dim3(4096), dim3(256), 0, stream, a, l); hipLaunchKernelGGL(k_naive_bcd<2>, dim3(4096), dim3(256), 0, stream, a, l); hipLaunchKernelGGL(k_naive_nsa, dim3(1024), dim3(256), 0, stream, a, l); continue; }
#endif
        a.ph_lo = p; a.ph_hi = p + 1; hipLaunchKernelGGL(fwd, dim3(grid), dim3(NTHR), LDS_BYTES, stream, a); }
#else
    a.ph_lo = 0; a.ph_hi = N_PHASES; hipLaunchKernelGGL(fwd, dim3(grid), dim3(NTHR), LDS_BYTES, stream, a);
#endif
}
```
